# Optimizing an MI355X kernel written in HIP

```python
import jax, jax.numpy as jnp
from jax import lax
import numpy as np

D_MODEL = 1024
BATCH = 2
SEQ = 8192
DEPTH = 4

GRID_W = 64
CTX_LEN = 256
EPS = 1e-6
NEG_INF = -1e30

NA_HEADS = 8
NA_HEAD_DIM = 64
NA_WIDTH = NA_HEADS * NA_HEAD_DIM
NA_KH = 8
NA_KW = 16
SGU_GROUPS = 8
SGU_WIDTH = D_MODEL - NA_WIDTH
SGU_GROUP_DIM = SGU_WIDTH // SGU_GROUPS
SGU_CHUNK = 128
HYB_IN = 3 * NA_WIDTH + 2 * SGU_WIDTH

RET_HEADS = 8
RET_QK_DIM = D_MODEL // RET_HEADS
RET_V_DIM = 2 * RET_QK_DIM
RET_QK_WIDTH = RET_HEADS * RET_QK_DIM
RET_V_WIDTH = RET_HEADS * RET_V_DIM
RET_CHUNK = 128
RET_IN = 2 * RET_QK_WIDTH + 2 * RET_V_WIDTH
ROPE_BASE = 10000.0

D_FF = 2816
CONV_W = 3

N_EVEN = (DEPTH + 1) // 2
N_ODD = DEPTH // 2

kernel_name = "hybrid_na_sgu_retention_dit_trunk"


def rmsnorm(x, g):
    xf = x.astype(jnp.float32)
    y = xf * lax.rsqrt(jnp.mean(xf * xf, axis=-1, keepdims=True) + EPS)
    return (y * g.astype(jnp.float32)).astype(x.dtype)


def modulate(x, shift, scale):
    return x * (1 + scale) + shift


def axial_rope(n_tokens, head_dim):
    t = jnp.arange(n_tokens)
    row = (t // GRID_W).astype(jnp.float32)
    col = (t % GRID_W).astype(jnp.float32)
    n_freq = head_dim // 4
    inv = ROPE_BASE ** (-jnp.arange(n_freq, dtype=jnp.float32) / n_freq)
    ang = jnp.concatenate([row[:, None] * inv, col[:, None] * inv], axis=-1)
    return jnp.cos(ang), jnp.sin(ang)


def apply_rope(x, cos, sin):
    x1, x2 = jnp.split(x, 2, axis=-1)
    c = cos[None, :, None, :]
    s = sin[None, :, None, :]
    return jnp.concatenate([x1 * c - x2 * s, x1 * s + x2 * c], axis=-1).astype(x.dtype)


def neighbourhood_attention(q, k, v, k_ctx, v_ctx, rpb):
    B, T, H, dh = q.shape
    rows = T // GRID_W
    kh = min(NA_KH, rows)
    kw = NA_KW
    scale = dh ** -0.5
    qg = q.reshape(B, rows, GRID_W, H, dh)
    kg = k.reshape(B, rows, GRID_W, H, dh)
    vg = v.reshape(B, rows, GRID_W, H, dh)
    r = jnp.arange(rows)
    r0 = jnp.clip(r - kh // 2, 0, rows - kh)
    key_rows = r0[:, None] + jnp.arange(kh)[None, :]
    k_blk = kg[:, key_rows].reshape(B, rows, kh * GRID_W, H, dh)
    v_blk = vg[:, key_rows].reshape(B, rows, kh * GRID_W, H, dh)
    s_nb = jnp.einsum('brqhd,brkhd->bhrqk', qg, k_blk,
                      preferred_element_type=jnp.float32) * scale
    cidx = jnp.arange(GRID_W)
    c0 = jnp.clip(cidx - kw // 2, 0, GRID_W - kw)
    in_win = (cidx[None, :] >= c0[:, None]) & (cidx[None, :] < c0[:, None] + kw)
    mask = jnp.broadcast_to(in_win[:, None, :], (GRID_W, kh, GRID_W)).reshape(GRID_W, kh * GRID_W)
    dr = key_rows - r[:, None] + (NA_KH - 1)
    dc = jnp.clip(cidx[None, :] - cidx[:, None], -(kw - 1), kw - 1) + (kw - 1)
    bias = rpb[:, dr[:, None, :, None], dc[None, :, None, :]]
    bias = bias.reshape(H, rows, GRID_W, kh * GRID_W).astype(jnp.float32)
    s_nb = jnp.where(mask, s_nb + bias[None], NEG_INF)
    s_cx = jnp.einsum('brqhd,bchd->bhrqc', qg, k_ctx,
                      preferred_element_type=jnp.float32) * scale
    p = jax.nn.softmax(jnp.concatenate([s_nb, s_cx], axis=-1), axis=-1)
    n_nb = kh * GRID_W
    p_nb = p[..., :n_nb].astype(v.dtype)
    p_cx = p[..., n_nb:].astype(v.dtype)
    o = (jnp.einsum('bhrqk,brkhd->brqhd', p_nb, v_blk)
         + jnp.einsum('bhrqc,bchd->brqhd', p_cx, v_ctx))
    return o.reshape(B, T, H * dh).astype(q.dtype)


def context_attention(q, k, v):
    B, L, H, dh = q.shape
    s = jnp.einsum('bqhd,bkhd->bhqk', q, k, preferred_element_type=jnp.float32) * dh ** -0.5
    p = jax.nn.softmax(s, axis=-1).astype(v.dtype)
    return jnp.einsum('bhqk,bkhd->bqhd', p, v).reshape(B, L, H * dh).astype(q.dtype)


def spatial_gating(u, v, w_s, b_s):
    B, N, _ = v.shape
    vf = v.astype(jnp.float32)
    mu = jnp.mean(vf, axis=-1, keepdims=True)
    var = jnp.mean(jnp.square(vf - mu), axis=-1, keepdims=True)
    vn = ((vf - mu) * lax.rsqrt(var + EPS)).astype(v.dtype)
    vc = vn.reshape(B, N // SGU_CHUNK, SGU_CHUNK, SGU_GROUPS, SGU_GROUP_DIM)
    mixed = jnp.einsum('gpq,bnqgc->bnpgc', w_s, vc) + b_s.T[None, None, :, :, None]
    return u * mixed.reshape(B, N, SGU_WIDTH)


def hybrid_na_sgu(h_ctx, h_lat, w_in, rpb, w_s, b_s, w_out, ctx_out):
    heads = lambda a: a.reshape(a.shape[0], a.shape[1], NA_HEADS, NA_HEAD_DIM)
    splits = [NA_WIDTH, 2 * NA_WIDTH, 3 * NA_WIDTH, 3 * NA_WIDTH + SGU_WIDTH]
    q, k, v, u, g = jnp.split(h_lat @ w_in, splits, axis=-1)
    if ctx_out:
        qc, kc, vc, uc, gc = jnp.split(h_ctx @ w_in, splits, axis=-1)
    else:
        kc, vc = jnp.split(h_ctx @ w_in[:, NA_WIDTH:3 * NA_WIDTH], 2, axis=-1)
    a_lat = neighbourhood_attention(heads(q), heads(k), heads(v), heads(kc), heads(vc), rpb)
    s_lat = spatial_gating(jax.nn.gelu(u), jax.nn.gelu(g), w_s, b_s)
    y_lat = jnp.concatenate([a_lat, s_lat], axis=-1) @ w_out
    y_ctx = None
    if ctx_out:
        a_ctx = context_attention(heads(qc), heads(kc), heads(vc))
        s_ctx = spatial_gating(jax.nn.gelu(uc), jax.nn.gelu(gc), w_s, b_s)
        y_ctx = jnp.concatenate([a_ctx, s_ctx], axis=-1) @ w_out
    return y_ctx, y_lat


def retention_chunked(q, k, v, lg, state0):
    B, N, H, dk = q.shape
    dv = v.shape[-1]
    C = RET_CHUNK
    n = N // C
    to_chunks = lambda a: a.reshape(B, n, C, H, a.shape[-1]).transpose(1, 0, 3, 2, 4)
    pos = jnp.arange(C, dtype=jnp.float32)
    diff = pos[:, None] - pos[None, :]
    lower = diff >= 0
    decay_intra = jnp.where(lower[None], jnp.exp(lg[:, None, None] * jnp.where(lower, diff, 0.0)[None]), 0.0)
    decay_q = jnp.exp(lg[:, None] * (pos + 1.0))[None, :, :, None]
    decay_k = jnp.exp(lg[:, None] * (C - 1.0 - pos))[None, :, :, None]
    decay_chunk = jnp.exp(lg * C)[None, :, None, None]

    def step(S, blk):
        qb, kb, vb = blk
        qf = qb.astype(jnp.float32)
        kf = kb.astype(jnp.float32)
        vf = vb.astype(jnp.float32)
        s = jnp.einsum('bhqd,bhkd->bhqk', qf, kf) * decay_intra
        o = jnp.einsum('bhqk,bhkv->bhqv', s, vf) + jnp.einsum('bhqd,bhdv->bhqv', qf * decay_q, S)
        S = S * decay_chunk + jnp.einsum('bhkd,bhkv->bhdv', kf * decay_k, vf)
        return S, o

    _, o = lax.scan(step, state0, (to_chunks(q), to_chunks(k), to_chunks(v)))
    return o.transpose(1, 0, 3, 2, 4).reshape(B, N, H, dv)


def retention_final_state(k, v, lg):
    L = k.shape[1]
    w = jnp.exp(lg[None, :] * (L - 1.0 - jnp.arange(L, dtype=jnp.float32))[:, None])
    return jnp.einsum('blhd,blhv->bhdv', k.astype(jnp.float32) * w[None, :, :, None], v.astype(jnp.float32))


def retention_output(o, g, gn_g, w_out):
    B, N = o.shape[0], o.shape[1]
    mu = jnp.mean(o, axis=-1, keepdims=True)
    var = jnp.mean(jnp.square(o - mu), axis=-1, keepdims=True)
    on = ((o - mu) * lax.rsqrt(var + EPS)).reshape(B, N, RET_V_WIDTH) * gn_g.astype(jnp.float32)
    return (jax.nn.silu(g) * on.astype(g.dtype)) @ w_out


def retention_mixer(h_ctx, h_lat, w_in, log_decay, gn_g, w_out, ctx_out):
    B, T, _ = h_lat.shape
    L = h_ctx.shape[1]
    H, dk, dv = RET_HEADS, RET_QK_DIM, RET_V_DIM
    splits = [RET_QK_WIDTH, 2 * RET_QK_WIDTH, 2 * RET_QK_WIDTH + RET_V_WIDTH]
    q, k, v, g = jnp.split(h_lat @ w_in, splits, axis=-1)
    cos, sin = axial_rope(T, dk)
    q = apply_rope(q.reshape(B, T, H, dk), cos, sin)
    k = apply_rope(k.reshape(B, T, H, dk) * dk ** -0.5, cos, sin)
    v = v.reshape(B, T, H, dv)
    if ctx_out:
        qc, kc, vc, gc = jnp.split(h_ctx @ w_in, splits, axis=-1)
        qc = qc.reshape(B, L, H, dk)
    else:
        kc, vc = jnp.split(h_ctx @ w_in[:, RET_QK_WIDTH:2 * RET_QK_WIDTH + RET_V_WIDTH], [RET_QK_WIDTH], axis=-1)
    kc = kc.reshape(B, L, H, dk) * dk ** -0.5
    vc = vc.reshape(B, L, H, dv)
    outs_lat = []
    outs_ctx = []
    for d in range(2):
        lg = log_decay[d].astype(jnp.float32)
        rev = (lambda a: a[:, ::-1]) if d == 1 else (lambda a: a)
        s_ctx = retention_final_state(rev(kc), rev(vc), lg)
        outs_lat.append(rev(retention_chunked(rev(q), rev(k), rev(v), lg, s_ctx)))
        if ctx_out:
            outs_ctx.append(rev(retention_chunked(rev(qc), rev(kc), rev(vc), lg, jnp.zeros_like(s_ctx))))
    y_lat = retention_output(outs_lat[0] + outs_lat[1], g, gn_g, w_out)
    y_ctx = None
    if ctx_out:
        y_ctx = retention_output(outs_ctx[0] + outs_ctx[1], gc, gn_g, w_out)
    return y_ctx, y_lat


def dwconv3(x, w, b):
    xp = jnp.pad(x, ((0, 0), (1, 1), (0, 0)))
    return xp[:, :-2] * w[0] + xp[:, 1:-1] * w[1] + xp[:, 2:] * w[2] + b


def conv_ffn(h, w_in, conv_w, conv_b, w_out):
    a = dwconv3(h @ w_in, conv_w, conv_b)
    gate, up = jnp.split(a, 2, axis=-1)
    return (jax.nn.silu(gate) * up) @ w_out


def setup_inputs(seed: int = 0) -> dict:
    key = jax.random.key(seed)
    ks = jax.random.split(key, 20)
    nrm = lambda k, shape, s: jax.random.normal(k, shape, jnp.float32) * s
    base_decay = np.log1p(-2.0 ** (-5.0 - np.arange(RET_HEADS))).astype(np.float32)
    return {
        "x": nrm(ks[0], (BATCH, SEQ, D_MODEL), 1.0),
        "c": nrm(ks[1], (BATCH, D_MODEL), 1.0),
        "ctx": nrm(ks[2], (BATCH, CTX_LEN, D_MODEL), 1.0),
        "c_ctx": nrm(ks[3], (D_MODEL,), 1.0),
        "ada_w": nrm(ks[4], (DEPTH, D_MODEL, 6 * D_MODEL), 0.5 * D_MODEL ** -0.5),
        "ada_b": nrm(ks[5], (DEPTH, 6 * D_MODEL), 0.02),
        "norm_g": 1.0 + nrm(ks[6], (DEPTH, 4, D_MODEL), 0.1),
        "hyb_w_in": nrm(ks[7], (N_EVEN, D_MODEL, HYB_IN), D_MODEL ** -0.5),
        "na_rpb": nrm(ks[8], (N_EVEN, NA_HEADS, 2 * NA_KH - 1, 2 * NA_KW - 1), 0.1),
        "sgu_w": nrm(ks[9], (N_EVEN, SGU_GROUPS, SGU_CHUNK, SGU_CHUNK), SGU_CHUNK ** -0.5),
        "sgu_b": 1.0 + nrm(ks[10], (N_EVEN, SGU_GROUPS, SGU_CHUNK), 0.1),
        "hyb_w_out": nrm(ks[11], (N_EVEN, D_MODEL, D_MODEL), D_MODEL ** -0.5),
        "ret_w_in": nrm(ks[12], (N_ODD, D_MODEL, RET_IN), D_MODEL ** -0.5),
        "ret_log_decay": jnp.asarray(base_decay)[None, None, :] * (1.0 + nrm(ks[13], (N_ODD, 2, RET_HEADS), 0.05)),
        "ret_gn_g": 1.0 + nrm(ks[14], (N_ODD, RET_V_WIDTH), 0.1),
        "ret_w_out": nrm(ks[15], (N_ODD, RET_V_WIDTH, D_MODEL), RET_V_WIDTH ** -0.5),
        "ffn_w_in": nrm(ks[16], (DEPTH, D_MODEL, 2 * D_FF), D_MODEL ** -0.5),
        "ffn_conv_w": nrm(ks[17], (DEPTH, CONV_W, 2 * D_FF), CONV_W ** -0.5),
        "ffn_conv_b": nrm(ks[18], (DEPTH, 2 * D_FF), 0.02),
        "ffn_w_out": nrm(ks[19], (DEPTH, D_FF, D_MODEL), D_FF ** -0.5),
    }


def reference(x, c, ctx, c_ctx, ada_w, ada_b, norm_g, hyb_w_in, na_rpb, sgu_w, sgu_b, hyb_w_out,
              ret_w_in, ret_log_decay, ret_gn_g, ret_w_out, ffn_w_in, ffn_conv_w, ffn_conv_b, ffn_w_out):
    xc = ctx
    silu_c = jax.nn.silu(c)
    silu_cc = jax.nn.silu(c_ctx)
    for i in range(DEPTH):
        ctx_out = i < DEPTH - 1
        j = i // 2
        mod_lat = (silu_c @ ada_w[i] + ada_b[i])[:, None, :]
        mod_ctx = (silu_cc @ ada_w[i] + ada_b[i])[None, None, :]
        sh1, sc1, g1, sh2, sc2, g2 = jnp.split(mod_lat, 6, axis=-1)
        csh1, csc1, cg1, csh2, csc2, cg2 = jnp.split(mod_ctx, 6, axis=-1)
        h_lat = modulate(rmsnorm(x, norm_g[i, 0]), sh1, sc1)
        h_ctx = modulate(rmsnorm(xc, norm_g[i, 0]), csh1, csc1)
        if i % 2 == 0:
            y_ctx, y_lat = hybrid_na_sgu(h_ctx, h_lat, hyb_w_in[j], na_rpb[j], sgu_w[j], sgu_b[j],
                                         hyb_w_out[j], ctx_out)
        else:
            y_ctx, y_lat = retention_mixer(h_ctx, h_lat, ret_w_in[j], ret_log_decay[j], ret_gn_g[j],
                                           ret_w_out[j], ctx_out)
        x = x + g1 * rmsnorm(y_lat, norm_g[i, 1])
        h = modulate(rmsnorm(x, norm_g[i, 2]), sh2, sc2)
        x = x + g2 * rmsnorm(conv_ffn(h, ffn_w_in[i], ffn_conv_w[i], ffn_conv_b[i], ffn_w_out[i]), norm_g[i, 3])
        if ctx_out:
            xc = xc + cg1 * rmsnorm(y_ctx, norm_g[i, 1])
            hc = modulate(rmsnorm(xc, norm_g[i, 2]), csh2, csc2)
            xc = xc + cg2 * rmsnorm(conv_ffn(hc, ffn_w_in[i], ffn_conv_w[i], ffn_conv_b[i], ffn_w_out[i]), norm_g[i, 3])
    return x
```

```cpp
#include <hip/hip_runtime.h>
#include <cstdio>
#include <cstdint>
__device__ __forceinline__ int tid_fresh() { int t = (int)threadIdx.x; asm volatile("" : "+v"(t)); return t; }
__device__ __forceinline__ int bid_fresh() { int t = (int)blockIdx.x; asm volatile("" : "+s"(t)); return t; }
__device__ __forceinline__ int grid_fresh() { int t = (int)gridDim.x; asm volatile("" : "+s"(t)); return t; }
namespace pg8 {
#define PG8_LAS __attribute__((address_space(3)))
typedef unsigned short bf16_t;
typedef short bf16x8 __attribute__((ext_vector_type(8)));
typedef float f32x4 __attribute__((ext_vector_type(4)));
typedef unsigned u32x4 __attribute__((ext_vector_type(4)));
constexpr int BM = 256, BK = 64, HALF = 128, HTB = HALF * BK * 2  , STAGE_BYTES = 8 * HTB, NXCD = 8, WGM = 8;

__host__ __device__ __forceinline__ int lds_byte(int r, int c) { const int st = (r >> 4) * 2 + (c >> 5), rr = r & 15, cc = c & 31, ob = rr * 64 + cc * 2; return st * 1024 + (ob ^ (((ob >> 9) & 1) << 5)); }
__host__ __device__ __forceinline__ void stage_rc(int b, int& R, int& C) { const int st = b / 1024, sb = b % 1024, swz = sb ^ (((sb >> 9) & 1) << 5); R = (st >> 1) * 16 + swz / 64; C = (st & 1) * 32 + (swz % 64) / 2; }
__host__ __device__ __forceinline__ int perm32(int rho) { const int n = rho >> 4, i = rho & 15; return 8 * (i >> 2) + 4 * n + (i & 3); }

struct Unit { int pm, pn; };
struct Gemm { const bf16_t* A; const bf16_t* Bt; int M, N, K; };

struct StaticOrder {
    int nM, nN, nwg, G, c;
    __host__ __device__ void init(int M, int N, int G_, int c_) { nM = M / BM; nN = N / BM; nwg = nM * nN; G = G_; c = c_; }
    __host__ __device__ bool next(int i, Unit& u) const {
        const long L = (long)i * G + c; if (L >= nwg) return false;
        int wgid = (int)L; { const int q = nwg / NXCD, r = nwg % NXCD, xcd = wgid % NXCD, off = wgid / NXCD; wgid = (xcd < r ? xcd * (q + 1) : r * (q + 1) + (xcd - r) * q) + off; }
        const int nig = WGM * nN, gid = wgid / nig, fm = gid * WGM, gsz = (nM - fm) < WGM ? (nM - fm) : WGM;
        u.pm = fm + ((wgid % nig) % gsz); u.pn = (wgid % nig) / gsz; return true;
    }
    __device__ __forceinline__ void a_ready(const Unit&) const {}
    __device__ __forceinline__ void done(const Unit&) const {}
};

__device__ __forceinline__ unsigned cvt_pk_bf16(float lo, float hi) { unsigned r; asm volatile("v_cvt_pk_bf16_f32 %0, %1, %2" : "=v"(r) : "v"(lo), "v"(hi)); return r; }
typedef float f32x2 __attribute__((ext_vector_type(2)));
__device__ __forceinline__ f32x2 gelu_pk(f32x2 v) {
    const f32x2 av = __builtin_elementwise_abs(v), d = av * 0.2316418882f + 1.0f;
    f32x2 t; t.x = __builtin_amdgcn_rcpf(d.x); t.y = __builtin_amdgcn_rcpf(d.y);
    f32x2 q = t * 0.5307027145f + (-0.7265760135f); q = q * t + 0.7107068705f; q = q * t + (-0.142248368f); q = q * t + 0.127414796f; q = q * t;
    const f32x2 s = (v * v) * (-0.72134752044f);
    f32x2 e; e.x = __builtin_amdgcn_exp2f(s.x); e.y = __builtin_amdgcn_exp2f(s.y);
    const f32x2 m = v * (q * e), r = v - m;
    f32x2 o; o.x = v.x < 0.f ? m.x : r.x; o.y = v.y < 0.f ? m.y : r.y; return o;
}

template <int ACT  > struct EpiBf16 {
    static constexpr bool PERM = true, AFTER_DRAIN = false; static_assert(ACT == 0 || ACT == 1, "EpiBf16: ACT is 0 (none) or 1 (gelu_pk)");
    bf16_t* O; int ldc; const float* bias; int split_cols; size_t split_stride; float scale0;
    __device__ __forceinline__ void operator()(const f32x4 (&acc)[2][2][4][2], const Unit& u, int wr, int wc, int fr, int fq) const {
        const int row0 = u.pm * BM + wr * 64 + fr; int colt = u.pn * BM; bf16_t* base = O;
        float sc = 1.f; if (split_cols) { const int t = colt / split_cols; base += (size_t)t * split_stride; colt -= t * split_cols; if (t == 0) sc = scale0; }
        const int col0 = colt + wc * 32 + 8 * fq, bcol0 = u.pn * BM + wc * 32 + 8 * fq;
        f32x4 bv[2][2];
#pragma unroll
        for (int bj = 0; bj < 2; ++bj)
#pragma unroll
            for (int n = 0; n < 2; ++n) bv[bj][n] = bias ? *(const f32x4*)(bias + bcol0 + bj * HALF + 4 * n) : (f32x4){0.f, 0.f, 0.f, 0.f};
#pragma unroll
        for (int ai = 0; ai < 2; ++ai)
#pragma unroll
            for (int m = 0; m < 4; ++m) { bf16_t* rowp = base + (size_t)(row0 + ai * HALF + m * 16) * ldc + col0;
#pragma unroll
                for (int bj = 0; bj < 2; ++bj) { f32x4 v0 = acc[ai][bj][m][0] + bv[bj][0], v1 = acc[ai][bj][m][1] + bv[bj][1];
                    if (ACT == 1) { f32x2 a = gelu_pk((f32x2){v0[0], v0[1]}), b = gelu_pk((f32x2){v0[2], v0[3]}), c = gelu_pk((f32x2){v1[0], v1[1]}), d = gelu_pk((f32x2){v1[2], v1[3]});
                        v0 = (f32x4){a.x, a.y, b.x, b.y}; v1 = (f32x4){c.x, c.y, d.x, d.y}; }
                    v0 = v0 * sc; v1 = v1 * sc; u32x4 w; w.x = cvt_pk_bf16(v0[0], v0[1]); w.y = cvt_pk_bf16(v0[2], v0[3]); w.z = cvt_pk_bf16(v1[0], v1[1]); w.w = cvt_pk_bf16(v1[2], v1[3]);
                    *(u32x4*)(rowp + bj * HALF) = w; } }
    }
};
struct EpiF32 {
    static constexpr bool PERM = false, AFTER_DRAIN = false;
    float* C; int ldc; const float* bias;
    __device__ __forceinline__ void operator()(const f32x4 (&acc)[2][2][4][2], const Unit& u, int wr, int wc, int fr, int fq) const {
        const int row0 = u.pm * BM + wr * 64 + fr, col0 = u.pn * BM + wc * 32 + 4 * fq;
        f32x4 bv[2][2];
#pragma unroll
        for (int bj = 0; bj < 2; ++bj)
#pragma unroll
            for (int n = 0; n < 2; ++n) bv[bj][n] = bias ? *(const f32x4*)(bias + col0 + bj * HALF + n * 16) : (f32x4){0.f, 0.f, 0.f, 0.f};
#pragma unroll
        for (int ai = 0; ai < 2; ++ai)
#pragma unroll
            for (int m = 0; m < 4; ++m) { float* rowp = C + (size_t)(row0 + ai * HALF + m * 16) * ldc + col0;
#pragma unroll
                for (int bj = 0; bj < 2; ++bj)
#pragma unroll
                    for (int n = 0; n < 2; ++n) *(f32x4*)(rowp + bj * HALF + n * 16) = acc[ai][bj][m][n] + bv[bj][n]; }
    }
};
template <class Epi, class Sched, bool ALIGN_EPI = false, bool SP2 = false>
__device__ __forceinline__ void gemm_phase(PG8_LAS unsigned char* lds, const Gemm g, const Sched& S, const Epi& E) {
    const int tid = tid_fresh(), wid = __builtin_amdgcn_readfirstlane(tid >> 6), lane = tid & 63, wr = wid >> 2, wc = wid & 3, fr = lane & 15, fq = lane >> 4;
    const int K = g.K, nt = K / BK;
    unsigned voffA[2], voffB[2];
#pragma unroll
    for (int i = 0; i < 2; ++i) { int R, C; stage_rc(tid * 16 + i * 8192, R, C); const int Rb = Epi::PERM ? ((R & ~31) + perm32(R & 31)) : R;
        voffA[i] = (unsigned)(R * K + C) * 2u; voffB[i] = (unsigned)(Rb * K + C) * 2u; }
    const size_t kstep = (size_t)(BK * 2);
    const size_t hstep = (size_t)HALF * K * 2;
    const size_t tstep = 2 * hstep;
    const unsigned ldsw = (unsigned)wid * 1024u;
    const int aoff = lds_byte(wr * 64 + fr, fq * 8), boff = lds_byte(wc * 32 + fr, fq * 8);
#define PG8_SA(b, h) (((b) * 2 + (h)) * HTB)
#define PG8_SB(b, h) ((4 + (b) * 2 + (h)) * HTB)
#define PG8_STAGE(bufoff, gbase, voff) do { _Pragma("unroll") for (int _i = 0; _i < 2; ++_i) \
        __builtin_amdgcn_global_load_lds((const unsigned*)((const char*)(gbase) + (voff)[_i]), (PG8_LAS unsigned*)(lds + (bufoff) + ldsw + _i * 8192), 16, 0, 0); } while (0)
#define PG8_LDA(dst, b, h) do { _Pragma("unroll") for (int m = 0; m < 4; ++m) _Pragma("unroll") for (int k = 0; k < 2; ++k) dst[m][k] = *(const PG8_LAS bf16x8*)(lds + PG8_SA(b, h) + aoff + m * 2048 + k * 1024); } while (0)
#define PG8_LDB(dst, b, h) do { _Pragma("unroll") for (int n = 0; n < 2; ++n) _Pragma("unroll") for (int k = 0; k < 2; ++k) dst[n][k] = *(const PG8_LAS bf16x8*)(lds + PG8_SB(b, h) + boff + n * 2048 + k * 1024); } while (0)
#define PG8_MMA(ai, bj, At, Bt) do { __builtin_amdgcn_s_setprio(1); _Pragma("unroll") for (int m = 0; m < 4; ++m) _Pragma("unroll") for (int n = 0; n < 2; ++n) _Pragma("unroll") for (int k = 0; k < 2; ++k) \
        acc[ai][bj][m][n] = __builtin_amdgcn_mfma_f32_16x16x32_bf16(Bt[n][k], At[m][k], acc[ai][bj][m][n], 0, 0, 0); __builtin_amdgcn_s_setprio(0); } while (0)
#define PG8_WAIT_V(n) asm volatile("s_waitcnt vmcnt(" #n ")" ::: "memory")
#define PG8_WAIT_L(n) asm volatile("s_waitcnt lgkmcnt(" #n ")" ::: "memory")
#define PG8_BAR __builtin_amdgcn_s_barrier()
#define PG8_SCHED __builtin_amdgcn_sched_barrier(0)
    Unit cur, nxt; int ui = 0;
    if (!S.next(0, cur)) return;
    f32x4 acc[2][2][4][2];
#pragma unroll
    for (int a = 0; a < 2; ++a)
#pragma unroll
        for (int b = 0; b < 2; ++b)
#pragma unroll
            for (int m = 0; m < 4; ++m)
#pragma unroll
                for (int n = 0; n < 2; ++n) acc[a][b][m][n] = (f32x4){0.f, 0.f, 0.f, 0.f};
    bf16x8 At[4][2], B0[2][2], B1[2][2];
    const char* cA = (const char*)g.A + (size_t)cur.pm * tstep; const char* cB = (const char*)g.Bt + (size_t)cur.pn * tstep;
    S.a_ready(cur);
    if constexpr (SP2) {
        PG8_STAGE(PG8_SB(0, 0), cB, voffB); PG8_STAGE(PG8_SB(0, 1), cB + hstep, voffB); PG8_STAGE(PG8_SA(0, 0), cA, voffA); PG8_STAGE(PG8_SA(0, 1), cA + hstep, voffA);
        if (wr == 1) PG8_BAR;
        PG8_WAIT_V(2); PG8_BAR;
        PG8_STAGE(PG8_SB(1, 0), cB + kstep, voffB); PG8_STAGE(PG8_SA(1, 0), cA + kstep, voffA); PG8_STAGE(PG8_SB(1, 1), cB + hstep + kstep, voffB);
        PG8_WAIT_V(6); PG8_BAR;
    } else {
        PG8_STAGE(PG8_SB(0, 0), cB, voffB); PG8_STAGE(PG8_SA(0, 0), cA, voffA); PG8_STAGE(PG8_SB(0, 1), cB + hstep, voffB); PG8_STAGE(PG8_SA(0, 1), cA + hstep, voffA);
        if (wr == 1) PG8_BAR;
        PG8_WAIT_V(4); PG8_BAR;
        PG8_STAGE(PG8_SB(1, 0), cB + kstep, voffB); PG8_STAGE(PG8_SA(1, 0), cA + kstep, voffA); PG8_STAGE(PG8_SB(1, 1), cB + hstep + kstep, voffB);
        PG8_WAIT_V(6); PG8_BAR;
    }
    for (;;) {
        const bool has_next = S.next(ui + 1, nxt);
        const char* nA = has_next ? (const char*)g.A + (size_t)nxt.pm * tstep : cA; const char* nB = has_next ? (const char*)g.Bt + (size_t)nxt.pn * tstep : cB;
        for (int t = 0; t < nt; t += 2) {
            const bool last = (t == nt - 2);
            const char* a1 = cA + (size_t)(t + 1) * kstep;
            const char* a2 = last ? nA : cA + (size_t)(t + 2) * kstep; const char* b2 = last ? nB : cB + (size_t)(t + 2) * kstep;
            const char* a3 = a2 + kstep; const char* b3 = b2 + kstep;
            if (last && has_next) S.a_ready(nxt);
            if constexpr (SP2) {
            PG8_LDB(B0, 0, 0); PG8_LDB(B1, 0, 1); PG8_SCHED; PG8_LDA(At, 0, 0); PG8_STAGE(PG8_SA(1, 1), a1 + hstep, voffA);
            PG8_WAIT_V(8); PG8_WAIT_L(0); PG8_BAR; PG8_MMA(0, 0, At, B0); PG8_MMA(0, 1, At, B1); PG8_BAR; PG8_SCHED;
            PG8_LDA(At, 0, 1); PG8_STAGE(PG8_SB(0, 0), b2, voffB); PG8_STAGE(PG8_SB(0, 1), b2 + hstep, voffB); PG8_STAGE(PG8_SA(0, 0), a2, voffA);
            PG8_WAIT_V(8); PG8_WAIT_L(0); PG8_BAR; PG8_MMA(1, 0, At, B0); PG8_MMA(1, 1, At, B1); PG8_BAR; PG8_SCHED;
            PG8_LDB(B0, 1, 0); PG8_LDB(B1, 1, 1); PG8_SCHED; PG8_LDA(At, 1, 0); PG8_STAGE(PG8_SA(0, 1), a2 + hstep, voffA);
            PG8_WAIT_V(8); PG8_WAIT_L(0); PG8_BAR; PG8_MMA(0, 0, At, B0); PG8_MMA(0, 1, At, B1); PG8_BAR; PG8_SCHED;
            PG8_LDA(At, 1, 1); PG8_STAGE(PG8_SB(1, 0), b3, voffB); PG8_STAGE(PG8_SB(1, 1), b3 + hstep, voffB); PG8_STAGE(PG8_SA(1, 0), a3, voffA);
            PG8_WAIT_V(8); PG8_WAIT_L(0); PG8_BAR; PG8_MMA(1, 0, At, B0); PG8_MMA(1, 1, At, B1); PG8_BAR; PG8_SCHED;
            } else {
            PG8_LDB(B0, 0, 0); PG8_SCHED; PG8_LDA(At, 0, 0); PG8_STAGE(PG8_SA(1, 1), a1 + hstep, voffA);
            PG8_WAIT_L(8); PG8_BAR; PG8_WAIT_L(0); PG8_MMA(0, 0, At, B0); PG8_BAR; PG8_SCHED;
            PG8_LDB(B1, 0, 1); PG8_STAGE(PG8_SB(0, 0), b2, voffB);
            PG8_BAR; PG8_WAIT_L(0); PG8_MMA(0, 1, At, B1); PG8_BAR;
            PG8_LDA(At, 0, 1); PG8_STAGE(PG8_SA(0, 0), a2, voffA);
            PG8_BAR; PG8_WAIT_L(0); PG8_MMA(1, 0, At, B0); PG8_BAR; PG8_SCHED;
            PG8_STAGE(PG8_SB(0, 1), b2 + hstep, voffB);
            PG8_WAIT_V(6); PG8_BAR; PG8_MMA(1, 1, At, B1); PG8_BAR;
            PG8_LDB(B0, 1, 0); PG8_SCHED; PG8_LDA(At, 1, 0); PG8_STAGE(PG8_SA(0, 1), a2 + hstep, voffA);
            PG8_WAIT_L(8); PG8_BAR; PG8_WAIT_L(0); PG8_MMA(0, 0, At, B0); PG8_BAR; PG8_SCHED;
            PG8_LDB(B1, 1, 1); PG8_STAGE(PG8_SB(1, 0), b3, voffB);
            PG8_BAR; PG8_WAIT_L(0); PG8_MMA(0, 1, At, B1); PG8_BAR;
            PG8_LDA(At, 1, 1); PG8_STAGE(PG8_SA(1, 0), a3, voffA);
            PG8_BAR; PG8_WAIT_L(0); PG8_MMA(1, 0, At, B0); PG8_BAR; PG8_SCHED;
            PG8_STAGE(PG8_SB(1, 1), b3 + hstep, voffB);
            PG8_WAIT_V(6); PG8_BAR; PG8_MMA(1, 1, At, B1); PG8_BAR;
            }
        }
        if constexpr (ALIGN_EPI) { if (wr == 0) PG8_BAR; }
        if constexpr (!Epi::AFTER_DRAIN) { E(acc, cur, wr, wc, fr, fq); S.done(cur); }
        if (!has_next) break;
#pragma unroll
        for (int a = 0; a < 2; ++a)
#pragma unroll
            for (int b = 0; b < 2; ++b)
#pragma unroll
                for (int m = 0; m < 4; ++m)
#pragma unroll
                    for (int n = 0; n < 2; ++n) acc[a][b][m][n] = (f32x4){0.f, 0.f, 0.f, 0.f};
        cur = nxt; cA = nA; cB = nB; ++ui;
        if constexpr (ALIGN_EPI) { if (wr == 1) PG8_BAR; }
    }
    PG8_WAIT_V(0);
    if constexpr (!ALIGN_EPI) { if (wr == 0) PG8_BAR; }
    PG8_BAR;
    if constexpr (Epi::AFTER_DRAIN) { E.fused(acc, cur, wr, wc, fr, fq, lds, wid, lane); S.done(cur); }
#undef PG8_SA
#undef PG8_SB
#undef PG8_STAGE
#undef PG8_LDA
#undef PG8_LDB
#undef PG8_MMA
#undef PG8_WAIT_V
#undef PG8_WAIT_L
#undef PG8_BAR
#undef PG8_SCHED
}
}
#define GAS __attribute__((address_space(1)))
#define LAS __attribute__((address_space(3)))
typedef unsigned short bf16;
typedef unsigned v4u __attribute__((ext_vector_type(4)));
typedef float f32x4 __attribute__((ext_vector_type(4)));
typedef short bf16x8 __attribute__((ext_vector_type(8)));
typedef GAS unsigned gu32;
typedef GAS unsigned long long gu64;
#define RLX_AGENT __ATOMIC_RELAXED, __HIP_MEMORY_SCOPE_AGENT
#define LDS_WAIT() asm volatile("s_waitcnt lgkmcnt(0)" ::: "memory")
#define VM_WAIT() asm volatile("s_waitcnt vmcnt(0)" ::: "memory")
__device__ __forceinline__ unsigned long long rt() { return __builtin_amdgcn_s_memrealtime(); }
__device__ __forceinline__ unsigned f2bf(float f) { unsigned u = __builtin_bit_cast(unsigned, f); return (u + 0x7fffu + ((u >> 16) & 1u)) >> 16; }
__device__ __forceinline__ unsigned pk2(float lo, float hi) { return f2bf(lo) | (f2bf(hi) << 16); }

#define XB_TMO      128
#define XB_XCNT(j)  (256  + 64 * (j))
#define XB_XSUB(j)  (1280 + 64 * (j))
#define XB_XGEN(j)  (2304 + 64 * (j))
#define XB_TOP      3328
#define XB_TOPGEN   3392
#define XCD_BAR_WORDS 3456
#define XB_SPIN_CAP (1u << 18)

__device__ __forceinline__ unsigned xb_ld(unsigned* p)              { return __hip_atomic_load(p, __ATOMIC_RELAXED, __HIP_MEMORY_SCOPE_AGENT); }
__device__ __forceinline__ unsigned xb_add(unsigned* p, unsigned v) { return __hip_atomic_fetch_add(p, v, __ATOMIC_RELAXED, __HIP_MEMORY_SCOPE_AGENT); }
__device__ __forceinline__ unsigned xb_xcc_id() { return (unsigned)__builtin_amdgcn_s_getreg((3 << 11) | 20) & 0xFu; }
#define XB_SPIN(cond, bar) do { unsigned _sp = 0; while (cond) { __builtin_amdgcn_s_sleep(1); \
    if ((++_sp & 255u) == 0u) { if (xb_ld(&(bar)[XB_TMO])) break; if (_sp > XB_SPIN_CAP) { atomicAdd(&(bar)[XB_TMO], 1u); break; } } } } while (0)

struct XcdBarrier {
    unsigned* bar; unsigned x;
    volatile LAS unsigned* st;
};

__device__ __forceinline__ XcdBarrier xcd_barrier_post(unsigned* bar, volatile LAS unsigned* st) {
    XcdBarrier b; b.bar = bar; b.x = xb_xcc_id(); b.st = st;
    if (threadIdx.x == 0) (void)xb_add(&bar[XB_XCNT(b.x)], 1u);
    return b;
}
__device__ __forceinline__ void xcd_barrier_complete(unsigned* bar, unsigned x, unsigned& nloc, unsigned& nx) {
    const unsigned G = gridDim.x * gridDim.y * gridDim.z;
    unsigned sum, cnt, mine, sp = 0u;
    for (;;) {
        sum = 0u; cnt = 0u; mine = 0u;
#pragma unroll
        for (unsigned j = 0; j < 16; ++j) { const unsigned c = xb_ld(&bar[XB_XCNT(j)]); sum += c; cnt += (c > 0u) ? 1u : 0u; mine = (j == x) ? c : mine; }
        if (sum == G) break;
        __builtin_amdgcn_s_sleep(1);
        if ((++sp & 255u) == 0u) { if (xb_ld(&bar[XB_TMO])) break; if (sp > XB_SPIN_CAP) { atomicAdd(&bar[XB_TMO], 1u); break; } }
    }
    nloc = mine > 0u ? mine : 1u; nx = cnt > 0u ? cnt : 1u;
}

__device__ __forceinline__ void xcd_barrier(const XcdBarrier& b) {
    asm volatile("s_waitcnt vmcnt(0)" ::: "memory");
    __syncthreads();
    if (threadIdx.x == 0) {
        unsigned* bar = b.bar;
        __builtin_amdgcn_s_waitcnt(0);
        unsigned nloc = b.st[0], nx = b.st[1];
        if (nloc == 0u) { xcd_barrier_complete(bar, b.x, nloc, nx); b.st[0] = nloc; b.st[1] = nx; }
        const unsigned old = xb_add(&bar[XB_XSUB(b.x)], 1u);
        const unsigned gen = old / nloc;
        if (old + 1u == (gen + 1u) * nloc) {
            __builtin_amdgcn_fence(__ATOMIC_RELEASE, "agent");
            asm volatile("s_waitcnt vmcnt(0)" ::: "memory");
            const unsigned og = xb_add(&bar[XB_TOP], 1u);
            const unsigned tg = og / nx;
            if (og + 1u == (tg + 1u) * nx) xb_add(&bar[XB_TOPGEN], 1u);
            else XB_SPIN(xb_ld(&bar[XB_TOPGEN]) == tg, bar);
            __builtin_amdgcn_fence(__ATOMIC_ACQUIRE, "agent");
            xb_add(&bar[XB_XGEN(b.x)], 1u);
            asm volatile("s_waitcnt vmcnt(0)" ::: "memory");
        } else {
            XB_SPIN(xb_ld(&bar[XB_XGEN(b.x)]) == gen, bar);
            __builtin_amdgcn_fence(__ATOMIC_ACQUIRE, "agent");
            asm volatile("s_waitcnt vmcnt(0)" ::: "memory");
        }
    }
    __syncthreads();
}

#ifndef PHMASK
#define PHMASK 0xffff
#endif
#ifndef ONE_LAUNCH
#define ONE_LAUNCH 1
#endif
constexpr int NWAVES = 8, NTHR = 512;
constexpr int NB = 2, T = 8192, LC = 256, D = 1024, RL = NB * T, RC = NB * LC, R = RL + RC, DEPTH = 4;
constexpr int HYB_IN = 2560, RET_IN = 6144, FF = 2816, FF2 = 5632;
constexpr float EPS = 1e-6f;
constexpr size_t MiB = 1u << 20;
constexpr size_t WS_CTL = 0, CTL_ZERO_BYTES = 1 * MiB;
constexpr size_t WS_MODS = 1 * MiB;
constexpr size_t WS_ROPE = 1 * MiB + 512 * 1024;
constexpr size_t WS_XCTX = 2 * MiB;
constexpr size_t WS_W = 16 * MiB;
constexpr size_t WS_H = 52 * MiB;
constexpr size_t WS_BIG1 = 86 * MiB;
constexpr size_t WS_BIG2 = 284 * MiB;
constexpr size_t WS_END = 375 * MiB;
constexpr size_t WO_IN = 0, WO_OUT = 6291456, WO_FIN = 8388608, WO_FOUT = 14155776;
constexpr int CW_BAR = 4096;
constexpr int RING_BYTES = 131072, LDSCTL_OFF = RING_BYTES, MISC_OFF = LDSCTL_OFF + 320, LDS_BYTES = 147456;
constexpr int NPHASE = 1 + 10 * DEPTH;

struct Params { const float* in[20]; float* out; unsigned char* ws; int ph_lo, ph_hi; };
__device__ __forceinline__ const Params& params() { const void* p = (const void*)__builtin_amdgcn_kernarg_segment_ptr(); asm volatile("" : "+s"(p)); return *(const Params*)p; }

__device__ __forceinline__ float bf2f(unsigned short b) { return __uint_as_float(((unsigned)b) << 16); }
__device__ __forceinline__ float bflo(unsigned u) { return __uint_as_float(u << 16); }
__device__ __forceinline__ float bfhi(unsigned u) { return __uint_as_float(u & 0xffff0000u); }
__device__ __forceinline__ float wave_sum(float v) {
#pragma unroll
    for (int o = 1; o < 64; o <<= 1) v += __shfl_xor(v, o);
    return v;
}
__device__ __forceinline__ float wave_max(float v) {
#pragma unroll
    for (int o = 1; o < 64; o <<= 1) v = fmaxf(v, __shfl_xor(v, o));
    return v;
}
__device__ __forceinline__ float silu_f(float x) { return x / (1.f + __expf(-x)); }
__device__ __forceinline__ float gelu_f(float x) { const float u = 0.7978845608028654f * (x + 0.044715f * x * x * x); return 0.5f * x * (1.f + tanhf(u)); }
__device__ __forceinline__ float* xrow(const Params& P, int r) { return r < RL ? P.out + (size_t)r * D : (float*)(P.ws + WS_XCTX) + (size_t)(r - RL) * D; }
__device__ __forceinline__ int modset(int r) { return r < RL ? (r >= T ? 1 : 0) : 2; }
__device__ __forceinline__ const float* modp(const Params& P, int layer, int set, int j) { return (const float*)(P.ws + WS_MODS) + ((size_t)((layer * 3 + set) * 6 + j)) * D; }

__device__ __forceinline__ void ph_init(const Params& P, unsigned char* lds) {
    const int tid = tid_fresh(), G = grid_fresh(), bid = bid_fresh();
    {
        const float4* xs = (const float4*)P.in[0]; float4* xd = (float4*)P.out;
        const size_t n4 = (size_t)RL * D / 4;
        for (size_t i = (size_t)bid * NTHR + tid; i < n4; i += (size_t)G * NTHR) xd[i] = xs[i];
        const float4* cs = (const float4*)P.in[2]; float4* cd = (float4*)(P.ws + WS_XCTX);
        const size_t m4 = (size_t)RC * D / 4;
        for (size_t i = (size_t)bid * NTHR + tid; i < m4; i += (size_t)G * NTHR) cd[i] = cs[i];
    }
    float* sv = (float*)lds;
    float* red = sv + 3072;
    float* mods = (float*)(P.ws + WS_MODS);
    for (int u = bid; u < DEPTH * 48; u += G) {
        const int l = u / 48, cb = u % 48;
        for (int i = tid; i < 3072; i += NTHR) { const int set = i >> 10, k = i & 1023; const float c = set < 2 ? P.in[1][set * D + k] : P.in[3][k]; sv[i] = c / (1.f + expf(-c)); }
        __syncthreads();
        const int kg = tid >> 7, nn = tid & 127, n = cb * 128 + nn;
        const float* w = P.in[4] + (size_t)l * D * 6144 + n;
        float a0 = 0.f, a1 = 0.f, a2 = 0.f;
#pragma unroll 8
        for (int k = kg * 256; k < kg * 256 + 256; ++k) { const float wv = w[(size_t)k * 6144]; a0 += sv[k] * wv; a1 += sv[1024 + k] * wv; a2 += sv[2048 + k] * wv; }
        red[(kg * 3 + 0) * 128 + nn] = a0; red[(kg * 3 + 1) * 128 + nn] = a1; red[(kg * 3 + 2) * 128 + nn] = a2;
        __syncthreads();
        if (tid < 384) { const int set = tid >> 7; float s = P.in[5][l * 6144 + n];
            s += red[(0 * 3 + set) * 128 + nn] + red[(1 * 3 + set) * 128 + nn] + red[(2 * 3 + set) * 128 + nn] + red[(3 * 3 + set) * 128 + nn];
            mods[(size_t)(l * 3 + set) * 6144 + n] = s; }
        __syncthreads();
    }
    float* tab = (float*)(P.ws + WS_ROPE);
    for (int i = bid * NTHR + tid; i < 192 * 32; i += G * NTHR) {
        const int p = i >> 5, f = i & 31; const float inv = powf(10000.f, -(float)f / 32.f); const float pos = (float)(p < 128 ? p : p - 128); const float ang = pos * inv;
        tab[2 * i] = cosf(ang); tab[2 * i + 1] = sinf(ang);
    }
}

__device__ __forceinline__ void transpose_item(const float* W, int K, int N, bf16* WT, LAS float* scr, int item, int lane) {
    const int nblk = N / 32, kb = item / nblk, nb = item % nblk, k0 = 64 * kb, n0 = 32 * nb;
#pragma unroll 8
    for (int i = 0; i < 32; ++i) { const int kk = 2 * i + (lane >> 5); scr[kk * 33 + (lane & 31)] = W[(size_t)(k0 + kk) * N + n0 + (lane & 31)]; }
    LDS_WAIT(); asm volatile("" ::: "memory");
    const int c = lane & 7;
#pragma unroll
    for (int j = 0; j < 4; ++j) { const int n = (lane >> 3) + 8 * j; const LAS float* s = scr + (8 * c) * 33 + n;
        v4u o; o.x = pk2(s[0 * 33], s[1 * 33]); o.y = pk2(s[2 * 33], s[3 * 33]); o.z = pk2(s[4 * 33], s[5 * 33]); o.w = pk2(s[6 * 33], s[7 * 33]);
        *(GAS v4u*)(WT + (size_t)(n0 + n) * K + k0 + 8 * c) = o; }
    LDS_WAIT(); asm volatile("" ::: "memory");
}
__device__ __forceinline__ void ph_wconv(const Params& P, int layer, LAS unsigned char* lds) {
    const int tid = tid_fresh(), lane = tid & 63, wave = __builtin_amdgcn_readfirstlane(tid >> 6);
    LAS float* scr = (LAS float*)(lds + wave * 16384);
    const int gw = bid_fresh() * NWAVES + wave, NGW = grid_fresh() * NWAVES;
    const int j = layer >> 1; const bool even = (layer & 1) == 0;
    bf16* WB = (bf16*)(P.ws + WS_W);
    const float* w_in = even ? P.in[7] + (size_t)j * D * HYB_IN : P.in[12] + (size_t)j * D * RET_IN;
    const int n_in = even ? HYB_IN : RET_IN;
    const float* w_out = even ? P.in[11] + (size_t)j * D * D : P.in[15] + (size_t)j * 2048 * D;
    const int k_out = even ? D : 2048;
    const float* wf_in = P.in[16] + (size_t)layer * D * FF2;
    const float* wf_out = P.in[19] + (size_t)layer * FF * D;
    const int I0 = (D / 64) * (n_in / 32), I1 = (k_out / 64) * (D / 32), I2 = (D / 64) * (FF2 / 32), I3 = (FF / 64) * (D / 32);
    const int NIT = I0 + I1 + I2 + I3;
    for (int it = gw; it < NIT; it += NGW) {
        int r = it;
        if (r < I0) { transpose_item(w_in, D, n_in, WB + WO_IN, scr, r, lane); continue; } r -= I0;
        if (r < I1) { transpose_item(w_out, k_out, D, WB + WO_OUT, scr, r, lane); continue; } r -= I1;
        if (r < I2) { transpose_item(wf_in, D, FF2, WB + WO_FIN, scr, r, lane); continue; } r -= I2;
        transpose_item(wf_out, FF, D, WB + WO_FOUT, scr, r, lane);
    }
}

__device__ __forceinline__ void ph_normmod(const Params& P, int layer) {
    const int tid = tid_fresh(), lane = tid & 63, wave = tid >> 6;
    const int gw = bid_fresh() * NWAVES + wave, NGW = grid_fresh() * NWAVES;
    bf16* H = (bf16*)(P.ws + WS_H);
    const float* ng = P.in[6] + (size_t)(layer * 4 + 0) * D;
    for (int r = gw; r < R; r += NGW) {
        const float4* xr = (const float4*)xrow(P, r) + lane;
        float4 v[4]; float ss = 0.f;
#pragma unroll
        for (int j = 0; j < 4; ++j) { v[j] = xr[64 * j]; ss += (v[j].x * v[j].x + v[j].y * v[j].y) + (v[j].z * v[j].z + v[j].w * v[j].w); }
        const float rs = 1.f / sqrtf(wave_sum(ss) * (1.f / D) + EPS);
        const int set = modset(r); const float* sh = modp(P, layer, set, 0); const float* sc = modp(P, layer, set, 1);
#pragma unroll
        for (int j = 0; j < 4; ++j) { const int col = 4 * lane + 256 * j;
            const float4 g4 = *(const float4*)(ng + col), sh4 = *(const float4*)(sh + col), sc4 = *(const float4*)(sc + col);
            const float o0 = v[j].x * rs * g4.x * (1.f + sc4.x) + sh4.x, o1 = v[j].y * rs * g4.y * (1.f + sc4.y) + sh4.y;
            const float o2 = v[j].z * rs * g4.z * (1.f + sc4.z) + sh4.z, o3 = v[j].w * rs * g4.w * (1.f + sc4.w) + sh4.w;
            uint2 w; w.x = pk2(o0, o1); w.y = pk2(o2, o3); *(uint2*)(H + (size_t)r * D + col) = w; }
    }
}
__device__ __forceinline__ void ph_resid(const Params& P, int layer, int stage) {
    const int tid = tid_fresh(), lane = tid & 63, wave = tid >> 6;
    const int gw = bid_fresh() * NWAVES + wave, NGW = grid_fresh() * NWAVES;
    bf16* H = (bf16*)(P.ws + WS_H); const float* Y = (const float*)(P.ws + WS_BIG1);
    const float* ngA = P.in[6] + (size_t)(layer * 4 + (stage == 1 ? 1 : 3)) * D;
    const float* ngB = P.in[6] + (size_t)(layer * 4 + 2) * D;
    const int rmax = (layer == DEPTH - 1) ? RL : R;
    for (int r = gw; r < rmax; r += NGW) {
        const float4* yr = (const float4*)(Y + (size_t)r * D) + lane; float4* xr = (float4*)xrow(P, r) + lane;
        float4 y[4]; float ss = 0.f;
#pragma unroll
        for (int j = 0; j < 4; ++j) { y[j] = yr[64 * j]; ss += (y[j].x * y[j].x + y[j].y * y[j].y) + (y[j].z * y[j].z + y[j].w * y[j].w); }
        const float rsy = 1.f / sqrtf(wave_sum(ss) * (1.f / D) + EPS);
        const int set = modset(r); const float* gate = modp(P, layer, set, stage == 1 ? 2 : 5);
        float4 x[4]; float sx = 0.f;
#pragma unroll
        for (int j = 0; j < 4; ++j) { const int col = 4 * lane + 256 * j; const float4 g4 = *(const float4*)(ngA + col), gt = *(const float4*)(gate + col); float4 xv = xr[64 * j];
            xv.x += gt.x * (y[j].x * rsy * g4.x); xv.y += gt.y * (y[j].y * rsy * g4.y); xv.z += gt.z * (y[j].z * rsy * g4.z); xv.w += gt.w * (y[j].w * rsy * g4.w);
            x[j] = xv; xr[64 * j] = xv; sx += (xv.x * xv.x + xv.y * xv.y) + (xv.z * xv.z + xv.w * xv.w); }
        if (stage == 1) {
            const float rs = 1.f / sqrtf(wave_sum(sx) * (1.f / D) + EPS);
            const float* sh = modp(P, layer, set, 3); const float* sc = modp(P, layer, set, 4);
#pragma unroll
            for (int j = 0; j < 4; ++j) { const int col = 4 * lane + 256 * j;
                const float4 g4 = *(const float4*)(ngB + col), sh4 = *(const float4*)(sh + col), sc4 = *(const float4*)(sc + col);
                const float o0 = x[j].x * rs * g4.x * (1.f + sc4.x) + sh4.x, o1 = x[j].y * rs * g4.y * (1.f + sc4.y) + sh4.y;
                const float o2 = x[j].z * rs * g4.z * (1.f + sc4.z) + sh4.z, o3 = x[j].w * rs * g4.w * (1.f + sc4.w) + sh4.w;
                uint2 w; w.x = pk2(o0, o1); w.y = pk2(o2, o3); *(uint2*)(H + (size_t)r * D + col) = w; }
        }
    }
}

__device__ __forceinline__ void ph_attn(const Params& P, int layer, unsigned char* lds) {
    const int tid = tid_fresh(), lane = tid & 63, wave = tid >> 6;
    const int gw = bid_fresh() * NWAVES + wave, NGW = grid_fresh() * NWAVES;
    const bf16* QKV = (const bf16*)(P.ws + WS_BIG1); bf16* O = (bf16*)(P.ws + WS_BIG2);
    const float* rpb = P.in[8] + (size_t)(layer >> 1) * 8 * 15 * 31;
    float* pw = (float*)lds + wave * 384;
    for (int task = gw; task < R * 8; task += NGW) {
        const int row = task >> 3, h = task & 7;
        const bool isctx = row >= RL;
        int b, qr = 0, qc = 0, r0 = 0, c0 = 0;
        if (!isctx) { b = row / T; const int t = row % T; qr = t >> 6; qc = t & 63; r0 = min(max(qr - 4, 0), 120); c0 = min(max(qc - 8, 0), 48); }
        else b = (row - RL) / LC;
        const int ctxbase = RL + b * LC;
        unsigned q[32];
        { const uint4* qp = (const uint4*)(QKV + (size_t)row * HYB_IN + h * 64);
#pragma unroll
          for (int i = 0; i < 8; ++i) { const uint4 w = qp[i]; q[4 * i + 0] = w.x; q[4 * i + 1] = w.y; q[4 * i + 2] = w.z; q[4 * i + 3] = w.w; } }
        const int nk = isctx ? 256 : 384;
        float sc[6]; float mx = -3.0e38f;
#pragma unroll
        for (int jj = 0; jj < 6; ++jj) {
            const int kk = lane + 64 * jj; float s = -3.0e38f;
            if (kk < nk) {
                int krow; float bias = 0.f;
                if (!isctx && kk < 128) { const int gr = r0 + (kk >> 4), gc = c0 + (kk & 15); krow = b * T + gr * 64 + gc;
                    const int dc = min(max(gc - qc, -15), 15) + 15; bias = rpb[h * 465 + (gr - qr + 7) * 31 + dc]; }
                else krow = ctxbase + (isctx ? kk : kk - 128);
                const uint4* kp = (const uint4*)(QKV + (size_t)krow * HYB_IN + 512 + h * 64);
                float dot = 0.f;
#pragma unroll
                for (int i = 0; i < 8; ++i) { const uint4 w = kp[i];
                    dot += bflo(q[4 * i + 0]) * bflo(w.x) + bfhi(q[4 * i + 0]) * bfhi(w.x) + bflo(q[4 * i + 1]) * bflo(w.y) + bfhi(q[4 * i + 1]) * bfhi(w.y)
                         + bflo(q[4 * i + 2]) * bflo(w.z) + bfhi(q[4 * i + 2]) * bfhi(w.z) + bflo(q[4 * i + 3]) * bflo(w.w) + bfhi(q[4 * i + 3]) * bfhi(w.w); }
                s = dot * 0.125f + bias;
            }
            asm volatile("" : "+v"(s) :: "memory");
            sc[jj] = s; mx = fmaxf(mx, s);
        }
        mx = wave_max(mx);
        float sum = 0.f;
#pragma unroll
        for (int jj = 0; jj < 6; ++jj) { const int kk = lane + 64 * jj; const float e = (kk < nk) ? __expf(sc[jj] - mx) : 0.f; sc[jj] = e; sum += e; }
        sum = wave_sum(sum); const float inv = 1.f / sum;
        asm volatile("s_waitcnt lgkmcnt(0)" ::: "memory"); __builtin_amdgcn_wave_barrier();
#pragma unroll
        for (int jj = 0; jj < 6; ++jj) { const int kk = lane + 64 * jj; if (kk < nk) pw[kk] = sc[jj] * inv; }
        asm volatile("s_waitcnt lgkmcnt(0)" ::: "memory"); __builtin_amdgcn_wave_barrier();
        float acc = 0.f;
        const bf16* Vb = QKV + 1024 + h * 64 + lane;
        if (!isctx) {
            for (int kk = 0; kk < 128; ++kk) { const int krow = b * T + (r0 + (kk >> 4)) * 64 + c0 + (kk & 15); acc += pw[kk] * bf2f(Vb[(size_t)krow * HYB_IN]); }
            for (int kk = 0; kk < 256; ++kk) acc += pw[128 + kk] * bf2f(Vb[(size_t)(ctxbase + kk) * HYB_IN]);
        } else {
            for (int kk = 0; kk < 256; ++kk) acc += pw[kk] * bf2f(Vb[(size_t)(ctxbase + kk) * HYB_IN]);
        }
        O[(size_t)row * D + h * 64 + lane] = (bf16)f2bf(acc);
    }
}

__device__ __forceinline__ void ph_sgu(const Params& P, int layer, unsigned char* lds) {
    const int tid = tid_fresh();
    const bf16* QKV = (const bf16*)(P.ws + WS_BIG1); bf16* O = (bf16*)(P.ws + WS_BIG2);
    const int j = layer >> 1;
    float* vn = (float*)lds;
    float* st = vn + 128 * 64;
    float* part = st + 256;
    for (int u = bid_fresh(); u < (R / 128) * 8; u += grid_fresh()) {
        const int ch = u >> 3, g = u & 7; const int row0 = ch * 128;
        {
            const int p = tid >> 2, qd = tid & 3; const bf16* gp = QKV + (size_t)(row0 + p) * HYB_IN + 2048 + qd * 128;
            float s = 0.f, s2 = 0.f;
            for (int c = 0; c < 128; ++c) { const float v = gelu_f(bf2f(gp[c])); s += v; s2 += v * v; }
            part[tid * 2] = s; part[tid * 2 + 1] = s2;
        }
        __syncthreads();
        if (tid < 128) { float s = 0.f, s2 = 0.f;
            for (int qd = 0; qd < 4; ++qd) { s += part[(tid * 4 + qd) * 2]; s2 += part[(tid * 4 + qd) * 2 + 1]; }
            const float mu = s * (1.f / 512.f); float var = s2 * (1.f / 512.f) - mu * mu; var = fmaxf(var, 0.f);
            st[tid * 2] = mu; st[tid * 2 + 1] = 1.f / sqrtf(var + EPS); }
        __syncthreads();
        for (int i = tid; i < 128 * 64; i += NTHR) { const int p = i >> 6, c = i & 63;
            const float v = gelu_f(bf2f(QKV[(size_t)(row0 + p) * HYB_IN + 2048 + g * 64 + c])); vn[i] = (v - st[p * 2]) * st[p * 2 + 1]; }
        __syncthreads();
        {
            const int c = tid & 63, pg = tid >> 6;
            const float* ws = P.in[9] + ((size_t)(j * 8 + g) * 128) * 128; const float* bs = P.in[10] + (size_t)(j * 8 + g) * 128;
            float acc[16];
#pragma unroll
            for (int i = 0; i < 16; ++i) acc[i] = 0.f;
            for (int q = 0; q < 128; ++q) { const float v = vn[q * 64 + c];
#pragma unroll
                for (int i = 0; i < 16; ++i) acc[i] += ws[(size_t)(pg * 16 + i) * 128 + q] * v; }
#pragma unroll
            for (int i = 0; i < 16; ++i) { const int p = pg * 16 + i; const float uu = gelu_f(bf2f(QKV[(size_t)(row0 + p) * HYB_IN + 1536 + g * 64 + c]));
                O[(size_t)(row0 + p) * D + 512 + g * 64 + c] = (bf16)f2bf(uu * (acc[i] + bs[p])); }
        }
        __syncthreads();
    }
}

__device__ __forceinline__ void ph_ret(const Params& P, int layer, unsigned char* lds) {
    const int tid = tid_fresh();
    const bf16* QKVG = (const bf16*)(P.ws + WS_BIG1); bf16* O = (bf16*)(P.ws + WS_BIG2);
    const float* tab = (const float*)(P.ws + WS_ROPE);
    const int j = layer >> 1;
    unsigned short* qs = (unsigned short*)lds;
    unsigned short* ks = qs + 128 * 130;
    float* vs = (float*)(lds + 2 * 128 * 130 * 2);
    float* Ss = vs + 128 * 32;
    float* et = Ss + 128 * 33;
    const int i = tid >> 2, jq = tid & 3;
    const float kscale = 0.08838834764831845f;
    for (int u = bid_fresh(); u < 128; u += grid_fresh()) {
        const int b = u >> 6, h = (u >> 3) & 7, vb = u & 7;
        for (int dir = 0; dir < 2; ++dir) {
            const float lg = P.in[13][(j * 2 + dir) * 8 + h];
            __syncthreads();
            for (int n = tid; n < 129; n += NTHR) et[n] = expf(lg * (float)n);
            for (int n = tid; n < 128 * 33; n += NTHR) Ss[n] = 0.f;
            __syncthreads();
            for (int c = 0; c < 66; ++c) {
                const bool isctx = c < 2; const int cc = isctx ? c : c - 2; const int nseq = isctx ? LC : T;
                {
                    const int ii = tid >> 2, dqr = tid & 3;
                    const int pp = cc * 128 + ii; const int tok = dir ? nseq - 1 - pp : pp; const int row = isctx ? RL + b * LC + tok : b * T + tok;
                    const bf16* qp = QKVG + (size_t)row * RET_IN + h * 128 + dqr * 16;
                    const bf16* kp = QKVG + (size_t)row * RET_IN + 1024 + h * 128 + dqr * 16;
                    const int gr = tok >> 6, gc = tok & 63;
#pragma unroll
                    for (int e = 0; e < 16; ++e) {
                        const int d = dqr * 16 + e;
                        float q1 = bf2f(qp[e]), q2 = bf2f(qp[64 + e]), k1 = bf2f(kp[e]) * kscale, k2 = bf2f(kp[64 + e]) * kscale;
                        if (!isctx) { const float* cs = (d < 32) ? tab + ((size_t)gr * 32 + d) * 2 : tab + ((size_t)(128 + gc) * 32 + (d - 32)) * 2; const float co = cs[0], si = cs[1];
                            const float a = q1 * co - q2 * si, bb = q1 * si + q2 * co; q1 = a; q2 = bb;
                            const float a2 = k1 * co - k2 * si, b2 = k1 * si + k2 * co; k1 = a2; k2 = b2; }
                        qs[ii * 130 + d] = (unsigned short)f2bf(q1); qs[ii * 130 + 64 + d] = (unsigned short)f2bf(q2);
                        ks[ii * 130 + d] = (unsigned short)f2bf(k1); ks[ii * 130 + 64 + d] = (unsigned short)f2bf(k2);
                    }
                    const bf16* vp = QKVG + (size_t)row * RET_IN + 2048 + h * 256 + vb * 32 + dqr * 8;
#pragma unroll
                    for (int e = 0; e < 8; ++e) vs[ii * 32 + dqr * 8 + e] = bf2f(vp[e]);
                }
                __syncthreads();
                float o[32];
#pragma unroll
                for (int v = 0; v < 32; ++v) o[v] = 0.f;
                for (int jj = 0; jj < 32; ++jj) {
                    const int jk = 32 * jq + jj;
                    float s = 0.f;
                    for (int d = 0; d < 128; d += 2) { const unsigned qa = *(const unsigned*)(qs + i * 130 + d), ka = *(const unsigned*)(ks + jk * 130 + d); s += bflo(qa) * bflo(ka) + bfhi(qa) * bfhi(ka); }
                    s = (jk <= i) ? s * et[(jk <= i) ? i - jk : 0] : 0.f;
#pragma unroll
                    for (int v = 0; v < 32; ++v) o[v] += s * vs[jk * 32 + v];
                }
                { const float dqi = et[i + 1];
                  for (int dd = 0; dd < 32; ++dd) { const int d = 32 * jq + dd; const float qd = bf2f(qs[i * 130 + d]) * dqi;
#pragma unroll
                      for (int v = 0; v < 32; ++v) o[v] += qd * Ss[d * 33 + v]; } }
#pragma unroll
                for (int v = 0; v < 32; ++v) { o[v] += __shfl_xor(o[v], 1); o[v] += __shfl_xor(o[v], 2); }
                {
                    const int pp = cc * 128 + i; const int tok = dir ? nseq - 1 - pp : pp; const int row = isctx ? RL + b * LC + tok : b * T + tok;
                    bf16* op = O + (size_t)row * 2048 + h * 256 + vb * 32 + jq * 8;
                    float w[8];
#pragma unroll
                    for (int v = 0; v < 32; ++v) if ((v >> 3) == jq) w[v & 7] = o[v];
                    if (dir) { const uint4 old = *(const uint4*)op; w[0] += bflo(old.x); w[1] += bfhi(old.x); w[2] += bflo(old.y); w[3] += bfhi(old.y); w[4] += bflo(old.z); w[5] += bfhi(old.z); w[6] += bflo(old.w); w[7] += bfhi(old.w); }
                    uint4 nw; nw.x = pk2(w[0], w[1]); nw.y = pk2(w[2], w[3]); nw.z = pk2(w[4], w[5]); nw.w = pk2(w[6], w[7]);
                    *(uint4*)op = nw;
                }
                __syncthreads();
                {
                    const int d = tid >> 2, v0 = (tid & 3) * 8; const float dc = et[128];
                    float a[8];
#pragma unroll
                    for (int v = 0; v < 8; ++v) a[v] = Ss[d * 33 + v0 + v] * dc;
                    for (int jk = 0; jk < 128; ++jk) { const float kd = bf2f(ks[jk * 130 + d]) * et[127 - jk];
#pragma unroll
                        for (int v = 0; v < 8; ++v) a[v] += kd * vs[jk * 32 + v0 + v]; }
#pragma unroll
                    for (int v = 0; v < 8; ++v) Ss[d * 33 + v0 + v] = a[v];
                }
                __syncthreads();
            }
            asm volatile("s_waitcnt vmcnt(0)" ::: "memory");
            __syncthreads();
        }
    }
}
__device__ __forceinline__ void ph_retnorm(const Params& P, int layer) {
    const int tid = tid_fresh(), lane = tid & 63, wave = tid >> 6;
    const int gw = bid_fresh() * NWAVES + wave, NGW = grid_fresh() * NWAVES;
    const bf16* QKVG = (const bf16*)(P.ws + WS_BIG1); bf16* O = (bf16*)(P.ws + WS_BIG2);
    const float* gn = P.in[14] + (size_t)(layer >> 1) * 2048;
    for (int r = gw; r < R; r += NGW) {
#pragma unroll
        for (int hh = 0; hh < 8; ++hh) {
            const int col = hh * 256 + 4 * lane;
            const uint2 ow = *(const uint2*)(O + (size_t)r * 2048 + col); const uint2 gw2 = *(const uint2*)(QKVG + (size_t)r * RET_IN + 4096 + col);
            float o0 = bflo(ow.x), o1 = bfhi(ow.x), o2 = bflo(ow.y), o3 = bfhi(ow.y);
            const float mu = wave_sum((o0 + o1) + (o2 + o3)) * (1.f / 256.f);
            o0 -= mu; o1 -= mu; o2 -= mu; o3 -= mu;
            const float var = wave_sum((o0 * o0 + o1 * o1) + (o2 * o2 + o3 * o3)) * (1.f / 256.f);
            const float rs = 1.f / sqrtf(var + EPS);
            const float4 g4 = *(const float4*)(gn + col);
            const float r0 = silu_f(bflo(gw2.x)) * (o0 * rs * g4.x), r1 = silu_f(bfhi(gw2.x)) * (o1 * rs * g4.y), r2 = silu_f(bflo(gw2.y)) * (o2 * rs * g4.z), r3 = silu_f(bfhi(gw2.y)) * (o3 * rs * g4.w);
            uint2 w; w.x = pk2(r0, r1); w.y = pk2(r2, r3); *(uint2*)(O + (size_t)r * 2048 + col) = w;
        }
    }
}

__device__ __forceinline__ void ph_conv(const Params& P, int layer) {
    const bf16* A = (const bf16*)(P.ws + WS_BIG1); bf16* O = (bf16*)(P.ws + WS_BIG2);
    const float* cw = P.in[17] + (size_t)layer * 3 * FF2; const float* cb = P.in[18] + (size_t)layer * FF2;
    const size_t nit = (size_t)R * (FF / 8);
    for (size_t it = (size_t)bid_fresh() * NTHR + tid_fresh(); it < nit; it += (size_t)grid_fresh() * NTHR) {
        const int r = (int)(it / (FF / 8)), c0 = (int)(it % (FF / 8)) * 8;
        int s, len; if (r < RL) { s = r % T; len = T; } else { s = (r - RL) % LC; len = LC; }
        const bool hp = s > 0, hn = s < len - 1;
        float res[8];
#pragma unroll
        for (int half = 0; half < 2; ++half) {
            const int c = c0 + half * FF;
            const uint4 z = make_uint4(0u, 0u, 0u, 0u);
            const uint4 am = hp ? *(const uint4*)(A + (size_t)(r - 1) * FF2 + c) : z;
            const uint4 a0 = *(const uint4*)(A + (size_t)r * FF2 + c);
            const uint4 ap = hn ? *(const uint4*)(A + (size_t)(r + 1) * FF2 + c) : z;
            const unsigned um[4] = {am.x, am.y, am.z, am.w}, u0[4] = {a0.x, a0.y, a0.z, a0.w}, up[4] = {ap.x, ap.y, ap.z, ap.w};
#pragma unroll
            for (int e = 0; e < 8; ++e) {
                const float vm = (e & 1) ? bfhi(um[e >> 1]) : bflo(um[e >> 1]), v0 = (e & 1) ? bfhi(u0[e >> 1]) : bflo(u0[e >> 1]), vp = (e & 1) ? bfhi(up[e >> 1]) : bflo(up[e >> 1]);
                const float cv = cw[c + e] * vm + cw[FF2 + c + e] * v0 + cw[2 * FF2 + c + e] * vp + cb[c + e];
                if (half == 0) res[e] = silu_f(cv); else res[e] *= cv;
            }
        }
        uint4 w; w.x = pk2(res[0], res[1]); w.y = pk2(res[2], res[3]); w.z = pk2(res[4], res[5]); w.w = pk2(res[6], res[7]);
        *(uint4*)(O + (size_t)r * FF + c0) = w;
    }
}

__device__ __forceinline__ void ph_gemm_bf16(LAS unsigned char* lds, const bf16* A, const bf16* Bt, bf16* O, int N, int K) {
    pg8::Gemm g{A, Bt, R, N, K}; pg8::StaticOrder S; S.init(R, N, (int)grid_fresh(), (int)bid_fresh());
    pg8::EpiBf16<0> E{O, N, nullptr, 0, 0, 1.f};
    pg8::gemm_phase<pg8::EpiBf16<0>, pg8::StaticOrder, true, true>(lds, g, S, E);
}
__device__ __forceinline__ void ph_gemm_f32(LAS unsigned char* lds, const bf16* A, const bf16* Bt, float* C, int N, int K) {
    pg8::Gemm g{A, Bt, R, N, K}; pg8::StaticOrder S; S.init(R, N, (int)grid_fresh(), (int)bid_fresh());
    pg8::EpiF32 E{C, N, nullptr};
    pg8::gemm_phase<pg8::EpiF32, pg8::StaticOrder, true, true>(lds, g, S, E);
}

__global__ void __launch_bounds__(NTHR, 2) fwd_kernel(Params P) {
    extern __shared__ __attribute__((aligned(16))) unsigned char lds[];
    LAS unsigned char* ldsl = (LAS unsigned char*)lds;
    const int tid = tid_fresh();
    gu32* ctl = (gu32*)(P.ws + WS_CTL);
#if ONE_LAUNCH
    for (int u = tid; u < (LDS_BYTES - LDSCTL_OFF) / 4; u += NTHR) ((LAS unsigned*)(ldsl + LDSCTL_OFF))[u] = 0u;
    __syncthreads();
    XcdBarrier bar = xcd_barrier_post((unsigned*)(ctl + CW_BAR), (volatile LAS unsigned*)(ldsl + MISC_OFF) + 8);
#endif
    const int ph_lo = P.ph_lo, ph_hi = P.ph_hi;
    for (int ph = ph_lo; ph < ph_hi; ++ph) {
        unsigned char* wsb = P.ws;
        bf16* WB = (bf16*)(wsb + WS_W); bf16* H = (bf16*)(wsb + WS_H); bf16* B1 = (bf16*)(wsb + WS_BIG1); bf16* B2 = (bf16*)(wsb + WS_BIG2);
        if (ph == 0) { if (PHMASK & 512) ph_init(P, lds); }
        else {
            const int layer = (ph - 1) / 10, st = (ph - 1) % 10; const bool even = (layer & 1) == 0;
            if ((PHMASK & 1) && (st == 1 || st == 6)) ph_gemm_bf16(ldsl, H, WB + (st == 1 ? WO_IN : WO_FIN), B1, st == 1 ? (even ? HYB_IN : RET_IN) : FF2, D);
            else if ((PHMASK & 2) && (st == 4 || st == 8)) ph_gemm_f32(ldsl, B2, WB + (st == 4 ? WO_OUT : WO_FOUT), (float*)B1, D, st == 4 ? (even ? D : 2048) : FF);
            else if ((PHMASK & 4) && st == 0) { ph_wconv(P, layer, ldsl); ph_normmod(P, layer); }
            else if ((PHMASK & 8) && st == 2 && even) { ph_attn(P, layer, lds); }
            else if ((PHMASK & 16) && st == 2 && !even) { ph_ret(P, layer, lds); }
            else if ((PHMASK & 32) && st == 3) { if (!even) ph_retnorm(P, layer); else ph_sgu(P, layer, lds); }
            else if ((PHMASK & 64) && st == 5) ph_resid(P, layer, 1);
            else if ((PHMASK & 128) && st == 7) ph_conv(P, layer);
            else if ((PHMASK & 256) && st == 9) ph_resid(P, layer, 2);
        }
#if ONE_LAUNCH
        if (ph + 1 < ph_hi) xcd_barrier(bar);
#endif
    }
}

extern "C" void kernel_launch(void* const* d_in, const int* in_sizes, int n_in, void* d_out, int out_size, void* d_ws, size_t ws_size, hipStream_t stream) {
    static int grid = 0;
    if (grid == 0) {
        if (n_in != 20 || out_size != RL * D || ws_size < WS_END) { fprintf(stderr, "kernel_launch: unexpected shapes (n_in %d out %d ws %zu)\n", n_in, out_size, ws_size); grid = -1; return; }
        int dev = 0, cus = 0;
        if (hipGetDevice(&dev) != hipSuccess || hipDeviceGetAttribute(&cus, hipDeviceAttributeMultiprocessorCount, dev) != hipSuccess) { grid = -1; return; }
        if (hipFuncSetAttribute((const void*)fwd_kernel, hipFuncAttributeMaxDynamicSharedMemorySize, LDS_BYTES) != hipSuccess) { grid = -1; return; }
        grid = cus;
    }
    if (grid < 0) return;
    (void)hipMemsetAsync((char*)d_ws + WS_CTL, 0, CTL_ZERO_BYTES, stream);
    Params p{};
    for (int i = 0; i < 20; ++i) p.in[i] = (const float*)d_in[i];
    p.out = (float*)d_out; p.ws = (unsigned char*)d_ws;
#if ONE_LAUNCH
    p.ph_lo = 0; p.ph_hi = NPHASE;
    hipLaunchKernelGGL(fwd_kernel, dim3(grid), dim3(NTHR), LDS_BYTES, stream, p);
#else
    for (int ph = 0; ph < NPHASE; ++ph) {
        const int st = ph == 0 ? -1 : (ph - 1) % 10; const int layer = ph == 0 ? 0 : (ph - 1) / 10;
        p.ph_lo = ph; p.ph_hi = ph + 1;
        hipLaunchKernelGGL(fwd_kernel, dim3(grid), dim3(NTHR), LDS_BYTES, stream, p);
    }
#endif
}
```

```cpp
#include <hip/hip_runtime.h>
#include <cstdio>
#include <cstdint>
__device__ __forceinline__ int tid_fresh() { int t = (int)threadIdx.x; asm volatile("" : "+v"(t)); return t; }
__device__ __forceinline__ int bid_fresh() { int t = (int)blockIdx.x; asm volatile("" : "+s"(t)); return t; }
__device__ __forceinline__ int grid_fresh() { int t = (int)gridDim.x; asm volatile("" : "+s"(t)); return t; }
namespace pg8 {
#define PG8_LAS __attribute__((address_space(3)))
typedef unsigned short bf16_t;
typedef short bf16x8 __attribute__((ext_vector_type(8)));
typedef float f32x4 __attribute__((ext_vector_type(4)));
typedef unsigned u32x4 __attribute__((ext_vector_type(4)));
constexpr int BM = 256, BK = 64, HALF = 128, HTB = HALF * BK * 2  , STAGE_BYTES = 8 * HTB, NXCD = 8, WGM = 8;

__host__ __device__ __forceinline__ int lds_byte(int r, int c) { const int st = (r >> 4) * 2 + (c >> 5), rr = r & 15, cc = c & 31, ob = rr * 64 + cc * 2; return st * 1024 + (ob ^ (((ob >> 9) & 1) << 5)); }
__host__ __device__ __forceinline__ void stage_rc(int b, int& R, int& C) { const int st = b / 1024, sb = b % 1024, swz = sb ^ (((sb >> 9) & 1) << 5); R = (st >> 1) * 16 + swz / 64; C = (st & 1) * 32 + (swz % 64) / 2; }
__host__ __device__ __forceinline__ int perm32(int rho) { const int n = rho >> 4, i = rho & 15; return 8 * (i >> 2) + 4 * n + (i & 3); }

struct Unit { int pm, pn; };
struct Gemm { const bf16_t* A; const bf16_t* Bt; int M, N, K, lda; };

struct StaticOrder {
    int nM, nN, nwg, G, c;
    __host__ __device__ void init(int M, int N, int G_, int c_) { nM = M / BM; nN = N / BM; nwg = nM * nN; G = G_; c = c_; }
    __host__ __device__ bool next(int i, Unit& u) const {
        const long L = (long)i * G + c; if (L >= nwg) return false;
        int wgid = (int)L; { const int q = nwg / NXCD, r = nwg % NXCD, xcd = wgid % NXCD, off = wgid / NXCD; wgid = (xcd < r ? xcd * (q + 1) : r * (q + 1) + (xcd - r) * q) + off; }
        const int nig = WGM * nN, gid = wgid / nig, fm = gid * WGM, gsz = (nM - fm) < WGM ? (nM - fm) : WGM;
        u.pm = fm + ((wgid % nig) % gsz); u.pn = (wgid % nig) / gsz; return true;
    }
    __device__ __forceinline__ void a_ready(const Unit&) const {}
    __device__ __forceinline__ void done(const Unit&) const {}
};

__device__ __forceinline__ unsigned cvt_pk_bf16(float lo, float hi) { unsigned r; asm volatile("v_cvt_pk_bf16_f32 %0, %1, %2" : "=v"(r) : "v"(lo), "v"(hi)); return r; }
typedef float f32x2 __attribute__((ext_vector_type(2)));
__device__ __forceinline__ f32x2 gelu_pk(f32x2 v) {
    const f32x2 av = __builtin_elementwise_abs(v), d = av * 0.2316418882f + 1.0f;
    f32x2 t; t.x = __builtin_amdgcn_rcpf(d.x); t.y = __builtin_amdgcn_rcpf(d.y);
    f32x2 q = t * 0.5307027145f + (-0.7265760135f); q = q * t + 0.7107068705f; q = q * t + (-0.142248368f); q = q * t + 0.127414796f; q = q * t;
    const f32x2 s = (v * v) * (-0.72134752044f);
    f32x2 e; e.x = __builtin_amdgcn_exp2f(s.x); e.y = __builtin_amdgcn_exp2f(s.y);
    const f32x2 m = v * (q * e), r = v - m;
    f32x2 o; o.x = v.x < 0.f ? m.x : r.x; o.y = v.y < 0.f ? m.y : r.y; return o;
}


struct EpiRet {
    static constexpr bool PERM = true, AFTER_DRAIN = false;
    bf16_t* O; const float* tab;
    __device__ __forceinline__ void operator()(const f32x4 (&acc)[2][2][4][2], const Unit& u, int wr, int wc, int fr, int fq) const {
        const int pn = u.pn; const bool lat = u.pm < 64;
        if (pn < 8) {
            const float ksc = pn >= 4 ? 0.08838834764831845f : 1.f;
            const int colbase = pn * 256 + (wc >> 1) * 128 + 32 * (wc & 1) + 8 * fq;
#pragma unroll
            for (int ai = 0; ai < 2; ++ai)
#pragma unroll
                for (int m = 0; m < 4; ++m) {
                    const int row = u.pm * BM + ai * HALF + wr * 64 + m * 16 + fr;
                    f32x4 c4[2], s4[2];
                    if (lat) { const int tk = row & 8191; const int prow = (wc & 1) ? 128 + (tk & 63) : (tk >> 6); const f32x4* tp = (const f32x4*)(tab + ((size_t)prow * 32 + 8 * fq) * 2);
                        const f32x4 t0 = tp[0], t1 = tp[1], t2 = tp[2], t3 = tp[3];
                        c4[0] = (f32x4){t0[0], t0[2], t1[0], t1[2]}; s4[0] = (f32x4){t0[1], t0[3], t1[1], t1[3]};
                        c4[1] = (f32x4){t2[0], t2[2], t3[0], t3[2]}; s4[1] = (f32x4){t2[1], t2[3], t3[1], t3[3]}; }
                    else { c4[0] = c4[1] = (f32x4){1.f, 1.f, 1.f, 1.f}; s4[0] = s4[1] = (f32x4){0.f, 0.f, 0.f, 0.f}; }
                    const f32x4 a0 = acc[ai][0][m][0] * ksc, a1 = acc[ai][0][m][1] * ksc, b0 = acc[ai][1][m][0] * ksc, b1 = acc[ai][1][m][1] * ksc;
                    const f32x4 o10 = a0 * c4[0] - b0 * s4[0], o11 = a1 * c4[1] - b1 * s4[1], o20 = a0 * s4[0] + b0 * c4[0], o21 = a1 * s4[1] + b1 * c4[1];
                    u32x4 w1, w2; w1.x = cvt_pk_bf16(o10[0], o10[1]); w1.y = cvt_pk_bf16(o10[2], o10[3]); w1.z = cvt_pk_bf16(o11[0], o11[1]); w1.w = cvt_pk_bf16(o11[2], o11[3]);
                    w2.x = cvt_pk_bf16(o20[0], o20[1]); w2.y = cvt_pk_bf16(o20[2], o20[3]); w2.z = cvt_pk_bf16(o21[0], o21[1]); w2.w = cvt_pk_bf16(o21[2], o21[3]);
                    bf16_t* rp = O + (size_t)row * 6144 + colbase; *(u32x4*)rp = w1; *(u32x4*)(rp + 64) = w2;
                }
        } else {
            const bool isg = pn >= 16; const int col0 = pn * BM + wc * 32 + 8 * fq;
#pragma unroll
            for (int ai = 0; ai < 2; ++ai)
#pragma unroll
                for (int m = 0; m < 4; ++m) { bf16_t* rowp = O + (size_t)(u.pm * BM + ai * HALF + wr * 64 + m * 16 + fr) * 6144 + col0;
#pragma unroll
                    for (int bj = 0; bj < 2; ++bj) { f32x4 v0 = acc[ai][bj][m][0], v1 = acc[ai][bj][m][1];
                        if (isg) {
#pragma unroll
                            for (int e = 0; e < 4; ++e) { v0[e] = v0[e] / (1.f + __expf(-v0[e])); v1[e] = v1[e] / (1.f + __expf(-v1[e])); } }
                        u32x4 w; w.x = cvt_pk_bf16(v0[0], v0[1]); w.y = cvt_pk_bf16(v0[2], v0[3]); w.z = cvt_pk_bf16(v1[0], v1[1]); w.w = cvt_pk_bf16(v1[2], v1[3]);
                        *(u32x4*)(rowp + bj * HALF) = w; } }
        }
    }
};
template <int ACT  > struct EpiBf16 {
    static constexpr bool PERM = true, AFTER_DRAIN = false; static_assert(ACT == 0 || ACT == 1, "EpiBf16: ACT is 0 (none) or 1 (gelu_pk)");
    bf16_t* O; int ldc; const float* bias; int split_cols; size_t split_stride; float scale0;
    __device__ __forceinline__ void operator()(const f32x4 (&acc)[2][2][4][2], const Unit& u, int wr, int wc, int fr, int fq) const {
        const int row0 = u.pm * BM + wr * 64 + fr; int colt = u.pn * BM; bf16_t* base = O;
        float sc = 1.f; if (split_cols) { const int t = colt / split_cols; base += (size_t)t * split_stride; colt -= t * split_cols; if (t == 0) sc = scale0; }
        const int col0 = colt + wc * 32 + 8 * fq, bcol0 = u.pn * BM + wc * 32 + 8 * fq;
        f32x4 bv[2][2];
#pragma unroll
        for (int bj = 0; bj < 2; ++bj)
#pragma unroll
            for (int n = 0; n < 2; ++n) bv[bj][n] = bias ? *(const f32x4*)(bias + bcol0 + bj * HALF + 4 * n) : (f32x4){0.f, 0.f, 0.f, 0.f};
#pragma unroll
        for (int ai = 0; ai < 2; ++ai)
#pragma unroll
            for (int m = 0; m < 4; ++m) { bf16_t* rowp = base + (size_t)(row0 + ai * HALF + m * 16) * ldc + col0;
#pragma unroll
                for (int bj = 0; bj < 2; ++bj) { f32x4 v0 = acc[ai][bj][m][0] + bv[bj][0], v1 = acc[ai][bj][m][1] + bv[bj][1];
                    if (ACT == 1) { f32x2 a = gelu_pk((f32x2){v0[0], v0[1]}), b = gelu_pk((f32x2){v0[2], v0[3]}), c = gelu_pk((f32x2){v1[0], v1[1]}), d = gelu_pk((f32x2){v1[2], v1[3]});
                        v0 = (f32x4){a.x, a.y, b.x, b.y}; v1 = (f32x4){c.x, c.y, d.x, d.y}; }
                    v0 = v0 * sc; v1 = v1 * sc; u32x4 w; w.x = cvt_pk_bf16(v0[0], v0[1]); w.y = cvt_pk_bf16(v0[2], v0[3]); w.z = cvt_pk_bf16(v1[0], v1[1]); w.w = cvt_pk_bf16(v1[2], v1[3]);
                    *(u32x4*)(rowp + bj * HALF) = w; } }
    }
};
struct EpiF32 {
    static constexpr bool PERM = false, AFTER_DRAIN = false;
    float* C; int ldc; const float* bias;
    __device__ __forceinline__ void operator()(const f32x4 (&acc)[2][2][4][2], const Unit& u, int wr, int wc, int fr, int fq) const {
        const int row0 = u.pm * BM + wr * 64 + fr, col0 = u.pn * BM + wc * 32 + 4 * fq;
        f32x4 bv[2][2];
#pragma unroll
        for (int bj = 0; bj < 2; ++bj)
#pragma unroll
            for (int n = 0; n < 2; ++n) bv[bj][n] = bias ? *(const f32x4*)(bias + col0 + bj * HALF + n * 16) : (f32x4){0.f, 0.f, 0.f, 0.f};
#pragma unroll
        for (int ai = 0; ai < 2; ++ai)
#pragma unroll
            for (int m = 0; m < 4; ++m) { float* rowp = C + (size_t)(row0 + ai * HALF + m * 16) * ldc + col0;
#pragma unroll
                for (int bj = 0; bj < 2; ++bj)
#pragma unroll
                    for (int n = 0; n < 2; ++n) *(f32x4*)(rowp + bj * HALF + n * 16) = acc[ai][bj][m][n] + bv[bj][n]; }
    }
};
template <class Epi, class Sched, bool ALIGN_EPI = false, bool SP2 = false>
__device__ __forceinline__ void gemm_phase(PG8_LAS unsigned char* lds, const Gemm g, const Sched& S, const Epi& E) {
    const int tid = tid_fresh(), wid = __builtin_amdgcn_readfirstlane(tid >> 6), lane = tid & 63, wr = wid >> 2, wc = wid & 3, fr = lane & 15, fq = lane >> 4;
    const int K = g.K, nt = K / BK;
    unsigned voffA[2], voffB[2];
#pragma unroll
    for (int i = 0; i < 2; ++i) { int R, C; stage_rc(tid * 16 + i * 8192, R, C); const int Rb = Epi::PERM ? ((R & ~31) + perm32(R & 31)) : R;
        voffA[i] = (unsigned)(R * g.lda + C) * 2u; voffB[i] = (unsigned)(Rb * K + C) * 2u; }
    const size_t kstep = (size_t)(BK * 2);
    const size_t hstepB = (size_t)HALF * K * 2, hstepA = (size_t)HALF * g.lda * 2;
    const size_t tstepB = 2 * hstepB, tstepA = 2 * hstepA;
    const unsigned ldsw = (unsigned)wid * 1024u;
    const int aoff = lds_byte(wr * 64 + fr, fq * 8), boff = lds_byte(wc * 32 + fr, fq * 8);
#define PG8_SA(b, h) (((b) * 2 + (h)) * HTB)
#define PG8_SB(b, h) ((4 + (b) * 2 + (h)) * HTB)
#define PG8_STAGE(bufoff, gbase, voff) do { _Pragma("unroll") for (int _i = 0; _i < 2; ++_i) \
        __builtin_amdgcn_global_load_lds((const unsigned*)((const char*)(gbase) + (voff)[_i]), (PG8_LAS unsigned*)(lds + (bufoff) + ldsw + _i * 8192), 16, 0, 0); } while (0)
#define PG8_LDA(dst, b, h) do { _Pragma("unroll") for (int m = 0; m < 4; ++m) _Pragma("unroll") for (int k = 0; k < 2; ++k) dst[m][k] = *(const PG8_LAS bf16x8*)(lds + PG8_SA(b, h) + aoff + m * 2048 + k * 1024); } while (0)
#define PG8_LDB(dst, b, h) do { _Pragma("unroll") for (int n = 0; n < 2; ++n) _Pragma("unroll") for (int k = 0; k < 2; ++k) dst[n][k] = *(const PG8_LAS bf16x8*)(lds + PG8_SB(b, h) + boff + n * 2048 + k * 1024); } while (0)
#define PG8_MMA(ai, bj, At, Bt) do { __builtin_amdgcn_s_setprio(1); _Pragma("unroll") for (int m = 0; m < 4; ++m) _Pragma("unroll") for (int n = 0; n < 2; ++n) _Pragma("unroll") for (int k = 0; k < 2; ++k) \
        acc[ai][bj][m][n] = __builtin_amdgcn_mfma_f32_16x16x32_bf16(Bt[n][k], At[m][k], acc[ai][bj][m][n], 0, 0, 0); __builtin_amdgcn_s_setprio(0); } while (0)
#define PG8_WAIT_V(n) asm volatile("s_waitcnt vmcnt(" #n ")" ::: "memory")
#define PG8_WAIT_L(n) asm volatile("s_waitcnt lgkmcnt(" #n ")" ::: "memory")
#define PG8_BAR __builtin_amdgcn_s_barrier()
#define PG8_SCHED __builtin_amdgcn_sched_barrier(0)
    Unit cur, nxt; int ui = 0;
    if (!S.next(0, cur)) return;
    f32x4 acc[2][2][4][2];
#pragma unroll
    for (int a = 0; a < 2; ++a)
#pragma unroll
        for (int b = 0; b < 2; ++b)
#pragma unroll
            for (int m = 0; m < 4; ++m)
#pragma unroll
                for (int n = 0; n < 2; ++n) acc[a][b][m][n] = (f32x4){0.f, 0.f, 0.f, 0.f};
    bf16x8 At[4][2], B0[2][2], B1[2][2];
    const char* cA = (const char*)g.A + (size_t)cur.pm * tstepA; const char* cB = (const char*)g.Bt + (size_t)cur.pn * tstepB;
    S.a_ready(cur);
    if constexpr (SP2) {
        PG8_STAGE(PG8_SB(0, 0), cB, voffB); PG8_STAGE(PG8_SB(0, 1), cB + hstepB, voffB); PG8_STAGE(PG8_SA(0, 0), cA, voffA); PG8_STAGE(PG8_SA(0, 1), cA + hstepA, voffA);
        if (wr == 1) PG8_BAR;
        PG8_WAIT_V(2); PG8_BAR;
        PG8_STAGE(PG8_SB(1, 0), cB + kstep, voffB); PG8_STAGE(PG8_SA(1, 0), cA + kstep, voffA); PG8_STAGE(PG8_SB(1, 1), cB + hstepB + kstep, voffB);
        PG8_WAIT_V(6); PG8_BAR;
    } else {
        PG8_STAGE(PG8_SB(0, 0), cB, voffB); PG8_STAGE(PG8_SA(0, 0), cA, voffA); PG8_STAGE(PG8_SB(0, 1), cB + hstepB, voffB); PG8_STAGE(PG8_SA(0, 1), cA + hstepA, voffA);
        if (wr == 1) PG8_BAR;
        PG8_WAIT_V(4); PG8_BAR;
        PG8_STAGE(PG8_SB(1, 0), cB + kstep, voffB); PG8_STAGE(PG8_SA(1, 0), cA + kstep, voffA); PG8_STAGE(PG8_SB(1, 1), cB + hstepB + kstep, voffB);
        PG8_WAIT_V(6); PG8_BAR;
    }
    for (;;) {
        const bool has_next = S.next(ui + 1, nxt);
        const char* nA = has_next ? (const char*)g.A + (size_t)nxt.pm * tstepA : cA; const char* nB = has_next ? (const char*)g.Bt + (size_t)nxt.pn * tstepB : cB;
        for (int t = 0; t < nt; t += 2) {
            const bool last = (t == nt - 2);
            const char* a1 = cA + (size_t)(t + 1) * kstep;
            const char* a2 = last ? nA : cA + (size_t)(t + 2) * kstep; const char* b2 = last ? nB : cB + (size_t)(t + 2) * kstep;
            const char* a3 = a2 + kstep; const char* b3 = b2 + kstep;
            if (last && has_next) S.a_ready(nxt);
            if constexpr (SP2) {
            PG8_LDB(B0, 0, 0); PG8_LDB(B1, 0, 1); PG8_SCHED; PG8_LDA(At, 0, 0); PG8_STAGE(PG8_SA(1, 1), a1 + hstepA, voffA);
            PG8_WAIT_V(8); PG8_WAIT_L(0); PG8_BAR; PG8_MMA(0, 0, At, B0); PG8_MMA(0, 1, At, B1); PG8_BAR; PG8_SCHED;
            PG8_LDA(At, 0, 1); PG8_STAGE(PG8_SB(0, 0), b2, voffB); PG8_STAGE(PG8_SB(0, 1), b2 + hstepB, voffB); PG8_STAGE(PG8_SA(0, 0), a2, voffA);
            PG8_WAIT_V(8); PG8_WAIT_L(0); PG8_BAR; PG8_MMA(1, 0, At, B0); PG8_MMA(1, 1, At, B1); PG8_BAR; PG8_SCHED;
            PG8_LDB(B0, 1, 0); PG8_LDB(B1, 1, 1); PG8_SCHED; PG8_LDA(At, 1, 0); PG8_STAGE(PG8_SA(0, 1), a2 + hstepA, voffA);
            PG8_WAIT_V(8); PG8_WAIT_L(0); PG8_BAR; PG8_MMA(0, 0, At, B0); PG8_MMA(0, 1, At, B1); PG8_BAR; PG8_SCHED;
            PG8_LDA(At, 1, 1); PG8_STAGE(PG8_SB(1, 0), b3, voffB); PG8_STAGE(PG8_SB(1, 1), b3 + hstepB, voffB); PG8_STAGE(PG8_SA(1, 0), a3, voffA);
            PG8_WAIT_V(8); PG8_WAIT_L(0); PG8_BAR; PG8_MMA(1, 0, At, B0); PG8_MMA(1, 1, At, B1); PG8_BAR; PG8_SCHED;
            } else {
            PG8_LDB(B0, 0, 0); PG8_SCHED; PG8_LDA(At, 0, 0); PG8_STAGE(PG8_SA(1, 1), a1 + hstepA, voffA);
            PG8_WAIT_L(8); PG8_BAR; PG8_WAIT_L(0); PG8_MMA(0, 0, At, B0); PG8_BAR; PG8_SCHED;
            PG8_LDB(B1, 0, 1); PG8_STAGE(PG8_SB(0, 0), b2, voffB);
            PG8_BAR; PG8_WAIT_L(0); PG8_MMA(0, 1, At, B1); PG8_BAR;
            PG8_LDA(At, 0, 1); PG8_STAGE(PG8_SA(0, 0), a2, voffA);
            PG8_BAR; PG8_WAIT_L(0); PG8_MMA(1, 0, At, B0); PG8_BAR; PG8_SCHED;
            PG8_STAGE(PG8_SB(0, 1), b2 + hstepB, voffB);
            PG8_WAIT_V(6); PG8_BAR; PG8_MMA(1, 1, At, B1); PG8_BAR;
            PG8_LDB(B0, 1, 0); PG8_SCHED; PG8_LDA(At, 1, 0); PG8_STAGE(PG8_SA(0, 1), a2 + hstepA, voffA);
            PG8_WAIT_L(8); PG8_BAR; PG8_WAIT_L(0); PG8_MMA(0, 0, At, B0); PG8_BAR; PG8_SCHED;
            PG8_LDB(B1, 1, 1); PG8_STAGE(PG8_SB(1, 0), b3, voffB);
            PG8_BAR; PG8_WAIT_L(0); PG8_MMA(0, 1, At, B1); PG8_BAR;
            PG8_LDA(At, 1, 1); PG8_STAGE(PG8_SA(1, 0), a3, voffA);
            PG8_BAR; PG8_WAIT_L(0); PG8_MMA(1, 0, At, B0); PG8_BAR; PG8_SCHED;
            PG8_STAGE(PG8_SB(1, 1), b3 + hstepB, voffB);
            PG8_WAIT_V(6); PG8_BAR; PG8_MMA(1, 1, At, B1); PG8_BAR;
            }
        }
        if constexpr (ALIGN_EPI) { if (wr == 0) PG8_BAR; }
        if constexpr (!Epi::AFTER_DRAIN) { E(acc, cur, wr, wc, fr, fq); S.done(cur); }
        if (!has_next) break;
#pragma unroll
        for (int a = 0; a < 2; ++a)
#pragma unroll
            for (int b = 0; b < 2; ++b)
#pragma unroll
                for (int m = 0; m < 4; ++m)
#pragma unroll
                    for (int n = 0; n < 2; ++n) acc[a][b][m][n] = (f32x4){0.f, 0.f, 0.f, 0.f};
        cur = nxt; cA = nA; cB = nB; ++ui;
        if constexpr (ALIGN_EPI) { if (wr == 1) PG8_BAR; }
    }
    PG8_WAIT_V(0);
    if constexpr (!ALIGN_EPI) { if (wr == 0) PG8_BAR; }
    PG8_BAR;
    if constexpr (Epi::AFTER_DRAIN) { E.fused(acc, cur, wr, wc, fr, fq, lds, wid, lane); S.done(cur); }
#undef PG8_SA
#undef PG8_SB
#undef PG8_STAGE
#undef PG8_LDA
#undef PG8_LDB
#undef PG8_MMA
#undef PG8_WAIT_V
#undef PG8_WAIT_L
#undef PG8_BAR
#undef PG8_SCHED
}
}
#define GAS __attribute__((address_space(1)))
#define LAS __attribute__((address_space(3)))
typedef unsigned short bf16;
typedef unsigned v4u __attribute__((ext_vector_type(4)));
typedef float f32x4 __attribute__((ext_vector_type(4)));
typedef short bf16x8 __attribute__((ext_vector_type(8)));
typedef GAS unsigned gu32;
typedef GAS unsigned long long gu64;
#define RLX_AGENT __ATOMIC_RELAXED, __HIP_MEMORY_SCOPE_AGENT
#define LDS_WAIT() asm volatile("s_waitcnt lgkmcnt(0)" ::: "memory")
#define VM_WAIT() asm volatile("s_waitcnt vmcnt(0)" ::: "memory")
__device__ __forceinline__ unsigned long long rt() { return __builtin_amdgcn_s_memrealtime(); }
__device__ __forceinline__ unsigned f2bf(float f) { unsigned u = __builtin_bit_cast(unsigned, f); return (u + 0x7fffu + ((u >> 16) & 1u)) >> 16; }
__device__ __forceinline__ unsigned pk2(float lo, float hi) { return f2bf(lo) | (f2bf(hi) << 16); }

#define XB_TMO      128
#define XB_XCNT(j)  (256  + 64 * (j))
#define XB_XSUB(j)  (1280 + 64 * (j))
#define XB_XGEN(j)  (2304 + 64 * (j))
#define XB_TOP      3328
#define XB_TOPGEN   3392
#define XCD_BAR_WORDS 3456
#define XB_SPIN_CAP (1u << 18)

__device__ __forceinline__ unsigned xb_ld(unsigned* p)              { return __hip_atomic_load(p, __ATOMIC_RELAXED, __HIP_MEMORY_SCOPE_AGENT); }
__device__ __forceinline__ unsigned xb_add(unsigned* p, unsigned v) { return __hip_atomic_fetch_add(p, v, __ATOMIC_RELAXED, __HIP_MEMORY_SCOPE_AGENT); }
__device__ __forceinline__ unsigned xb_xcc_id() { return (unsigned)__builtin_amdgcn_s_getreg((3 << 11) | 20) & 0xFu; }
#define XB_SPIN(cond, bar) do { unsigned _sp = 0; while (cond) { __builtin_amdgcn_s_sleep(1); \
    if ((++_sp & 255u) == 0u) { if (xb_ld(&(bar)[XB_TMO])) break; if (_sp > XB_SPIN_CAP) { atomicAdd(&(bar)[XB_TMO], 1u); break; } } } } while (0)

struct XcdBarrier {
    unsigned* bar; unsigned x;
    volatile LAS unsigned* st;
};

__device__ __forceinline__ XcdBarrier xcd_barrier_post(unsigned* bar, volatile LAS unsigned* st) {
    XcdBarrier b; b.bar = bar; b.x = xb_xcc_id(); b.st = st;
    if (threadIdx.x == 0) (void)xb_add(&bar[XB_XCNT(b.x)], 1u);
    return b;
}
__device__ __forceinline__ void xcd_barrier_complete(unsigned* bar, unsigned x, unsigned& nloc, unsigned& nx) {
    const unsigned G = gridDim.x * gridDim.y * gridDim.z;
    unsigned sum, cnt, mine, sp = 0u;
    for (;;) {
        sum = 0u; cnt = 0u; mine = 0u;
#pragma unroll
        for (unsigned j = 0; j < 16; ++j) { const unsigned c = xb_ld(&bar[XB_XCNT(j)]); sum += c; cnt += (c > 0u) ? 1u : 0u; mine = (j == x) ? c : mine; }
        if (sum == G) break;
        __builtin_amdgcn_s_sleep(1);
        if ((++sp & 255u) == 0u) { if (xb_ld(&bar[XB_TMO])) break; if (sp > XB_SPIN_CAP) { atomicAdd(&bar[XB_TMO], 1u); break; } }
    }
    nloc = mine > 0u ? mine : 1u; nx = cnt > 0u ? cnt : 1u;
}

__device__ __forceinline__ void xcd_barrier(const XcdBarrier& b) {
    asm volatile("s_waitcnt vmcnt(0)" ::: "memory");
    __syncthreads();
    if (threadIdx.x == 0) {
        unsigned* bar = b.bar;
        __builtin_amdgcn_s_waitcnt(0);
        unsigned nloc = b.st[0], nx = b.st[1];
        if (nloc == 0u) { xcd_barrier_complete(bar, b.x, nloc, nx); b.st[0] = nloc; b.st[1] = nx; }
        const unsigned old = xb_add(&bar[XB_XSUB(b.x)], 1u);
        const unsigned gen = old / nloc;
        if (old + 1u == (gen + 1u) * nloc) {
            __builtin_amdgcn_fence(__ATOMIC_RELEASE, "agent");
            asm volatile("s_waitcnt vmcnt(0)" ::: "memory");
            const unsigned og = xb_add(&bar[XB_TOP], 1u);
            const unsigned tg = og / nx;
            if (og + 1u == (tg + 1u) * nx) xb_add(&bar[XB_TOPGEN], 1u);
            else XB_SPIN(xb_ld(&bar[XB_TOPGEN]) == tg, bar);
            __builtin_amdgcn_fence(__ATOMIC_ACQUIRE, "agent");
            xb_add(&bar[XB_XGEN(b.x)], 1u);
            asm volatile("s_waitcnt vmcnt(0)" ::: "memory");
        } else {
            XB_SPIN(xb_ld(&bar[XB_XGEN(b.x)]) == gen, bar);
            __builtin_amdgcn_fence(__ATOMIC_ACQUIRE, "agent");
            asm volatile("s_waitcnt vmcnt(0)" ::: "memory");
        }
    }
    __syncthreads();
}

#ifndef PHMASK
#define PHMASK 0xffff
#endif
#ifndef ONE_LAUNCH
#define ONE_LAUNCH 1
#endif
constexpr int NWAVES = 8, NTHR = 512;
constexpr int NB = 2, T = 8192, LC = 256, D = 1024, RL = NB * T, RC = NB * LC, R = RL + RC, DEPTH = 4;
constexpr int HYB_IN = 2560, RET_IN = 6144, FF = 2816, FF2 = 5632;
constexpr float EPS = 1e-6f;
constexpr size_t MiB = 1u << 20;
constexpr size_t WS_CTL = 0, CTL_ZERO_BYTES = 1 * MiB;
constexpr size_t WS_MODS = 1 * MiB;
constexpr size_t WS_ROPE = 1 * MiB + 512 * 1024;
constexpr size_t WS_XCTX = 2 * MiB;
constexpr size_t WS_W = 8 * MiB;
constexpr size_t WS_H = 42 * MiB;
constexpr size_t WS_BIG2 = 75 * MiB;
constexpr size_t WS_BIG1 = 174 * MiB;
constexpr size_t WS_ST = WS_H;
constexpr size_t WS_END = 372 * MiB;
constexpr size_t WO_IN = 0, WO_OUT = 6291456, WO_FIN = 8388608, WO_FOUT = 14155776;
constexpr int CW_BAR = 4096;
constexpr int RING_BYTES = 131072, LDS_BYTES = 147456, LDSCTL_OFF = LDS_BYTES - 512, MISC_OFF = LDSCTL_OFF + 320;
constexpr int NPHASE = 41;

struct Params { const float* in[20]; float* out; unsigned char* ws; int ph_lo, ph_hi; };
__device__ __forceinline__ const Params& params() { const void* p = (const void*)__builtin_amdgcn_kernarg_segment_ptr(); asm volatile("" : "+s"(p)); return *(const Params*)p; }

__device__ __forceinline__ float bf2f(unsigned short b) { return __uint_as_float(((unsigned)b) << 16); }
__device__ __forceinline__ float bflo(unsigned u) { return __uint_as_float(u << 16); }
__device__ __forceinline__ float bfhi(unsigned u) { return __uint_as_float(u & 0xffff0000u); }
__device__ __forceinline__ float wave_sum(float v) {
#pragma unroll
    for (int o = 1; o < 64; o <<= 1) v += __shfl_xor(v, o);
    return v;
}
__device__ __forceinline__ float wave_max(float v) {
#pragma unroll
    for (int o = 1; o < 64; o <<= 1) v = fmaxf(v, __shfl_xor(v, o));
    return v;
}
__device__ __forceinline__ float silu_f(float x) { return x / (1.f + __expf(-x)); }
__device__ __forceinline__ float gelu_f(float x) { const float u = 0.7978845608028654f * (x + 0.044715f * x * x * x); return 0.5f * x * (1.f + tanhf(u)); }
__device__ __forceinline__ float* xrow(const Params& P, int r) { return r < RL ? P.out + (size_t)r * D : (float*)(P.ws + WS_XCTX) + (size_t)(r - RL) * D; }
__device__ __forceinline__ int modset(int r) { return r < RL ? (r >= T ? 1 : 0) : 2; }
__device__ __forceinline__ const float* modp(const Params& P, int layer, int set, int j) { return (const float*)(P.ws + WS_MODS) + ((size_t)((layer * 3 + set) * 6 + j)) * D; }

__device__ __forceinline__ void ph_init(const Params& P, unsigned char* lds) {
    const int tid = tid_fresh(), G = grid_fresh(), bid = bid_fresh();
    {
        const float4* xs = (const float4*)P.in[0]; float4* xd = (float4*)P.out;
        const size_t n4 = (size_t)RL * D / 4;
        for (size_t i = (size_t)bid * NTHR + tid; i < n4; i += (size_t)G * NTHR) xd[i] = xs[i];
        const float4* cs = (const float4*)P.in[2]; float4* cd = (float4*)(P.ws + WS_XCTX);
        const size_t m4 = (size_t)RC * D / 4;
        for (size_t i = (size_t)bid * NTHR + tid; i < m4; i += (size_t)G * NTHR) cd[i] = cs[i];
    }
    float* sv = (float*)lds;
    float* red = sv + 3072;
    float* mods = (float*)(P.ws + WS_MODS);
    for (int u = bid; u < DEPTH * 48; u += G) {
        const int l = u / 48, cb = u % 48;
        for (int i = tid; i < 3072; i += NTHR) { const int set = i >> 10, k = i & 1023; const float c = set < 2 ? P.in[1][set * D + k] : P.in[3][k]; sv[i] = c / (1.f + expf(-c)); }
        __syncthreads();
        const int kg = tid >> 7, nn = tid & 127, n = cb * 128 + nn;
        const float* w = P.in[4] + (size_t)l * D * 6144 + n;
        float a0 = 0.f, a1 = 0.f, a2 = 0.f;
#pragma unroll 8
        for (int k = kg * 256; k < kg * 256 + 256; ++k) { const float wv = w[(size_t)k * 6144]; a0 += sv[k] * wv; a1 += sv[1024 + k] * wv; a2 += sv[2048 + k] * wv; }
        red[(kg * 3 + 0) * 128 + nn] = a0; red[(kg * 3 + 1) * 128 + nn] = a1; red[(kg * 3 + 2) * 128 + nn] = a2;
        __syncthreads();
        if (tid < 384) { const int set = tid >> 7; float s = P.in[5][l * 6144 + n];
            s += red[(0 * 3 + set) * 128 + nn] + red[(1 * 3 + set) * 128 + nn] + red[(2 * 3 + set) * 128 + nn] + red[(3 * 3 + set) * 128 + nn];
            mods[(size_t)(l * 3 + set) * 6144 + n] = s; }
        __syncthreads();
    }
    float* tab = (float*)(P.ws + WS_ROPE);
    for (int i = bid * NTHR + tid; i < 192 * 32; i += G * NTHR) {
        const int p = i >> 5, f = i & 31; const float inv = powf(10000.f, -(float)f / 32.f); const float pos = (float)(p < 128 ? p : p - 128); const float ang = pos * inv;
        tab[2 * i] = cosf(ang); tab[2 * i + 1] = sinf(ang);
    }
}

__device__ __forceinline__ void transpose_item(const float* W, int K, int N, bf16* WT, LAS float* scr, int item, int lane, bool ropeperm = false) {
    const int nblk = N / 32, kb = item / nblk, nb = item % nblk, k0 = 64 * kb, n0 = 32 * nb;
    int nd = n0; if (ropeperm && n0 < 2048) { const int c = n0 & 255; nd = (n0 & ~255) + 128 * ((c >> 6) & 1) + 64 * (c >> 7) + (c & 63); }
#pragma unroll 8
    for (int i = 0; i < 32; ++i) { const int kk = 2 * i + (lane >> 5); scr[kk * 33 + (lane & 31)] = W[(size_t)(k0 + kk) * N + n0 + (lane & 31)]; }
    LDS_WAIT(); asm volatile("" ::: "memory");
    const int c = lane & 7;
#pragma unroll
    for (int j = 0; j < 4; ++j) { const int n = (lane >> 3) + 8 * j; const LAS float* s = scr + (8 * c) * 33 + n;
        v4u o; o.x = pk2(s[0 * 33], s[1 * 33]); o.y = pk2(s[2 * 33], s[3 * 33]); o.z = pk2(s[4 * 33], s[5 * 33]); o.w = pk2(s[6 * 33], s[7 * 33]);
        *(GAS v4u*)(WT + (size_t)(nd + n) * K + k0 + 8 * c) = o; }
    LDS_WAIT(); asm volatile("" ::: "memory");
}
__device__ __forceinline__ void ph_wconv(const Params& P, int layer, LAS unsigned char* lds) {
    const int tid = tid_fresh(), lane = tid & 63, wave = __builtin_amdgcn_readfirstlane(tid >> 6);
    LAS float* scr = (LAS float*)(lds + wave * 16384);
    const int gw = bid_fresh() * NWAVES + wave, NGW = grid_fresh() * NWAVES;
    const int j = layer >> 1; const bool even = (layer & 1) == 0;
    bf16* WB = (bf16*)(P.ws + WS_W);
    const float* w_in = even ? P.in[7] + (size_t)j * D * HYB_IN : P.in[12] + (size_t)j * D * RET_IN;
    const int n_in = even ? HYB_IN : RET_IN;
    const float* w_out = even ? P.in[11] + (size_t)j * D * D : P.in[15] + (size_t)j * 2048 * D;
    const int k_out = even ? D : 2048;
    const float* wf_in = P.in[16] + (size_t)layer * D * FF2;
    const float* wf_out = P.in[19] + (size_t)layer * FF * D;
    const int I0 = (D / 64) * (n_in / 32), I1 = (k_out / 64) * (D / 32), I2 = (D / 64) * (FF2 / 32), I3 = (FF / 64) * (D / 32);
    const int NIT = I0 + I1 + I2 + I3;
    for (int it = gw; it < NIT; it += NGW) {
        int r = it;
        if (r < I0) { transpose_item(w_in, D, n_in, WB + WO_IN, scr, r, lane, !even); continue; } r -= I0;
        if (r < I1) { transpose_item(w_out, k_out, D, WB + WO_OUT, scr, r, lane); continue; } r -= I1;
        if (r < I2) { transpose_item(wf_in, D, FF2, WB + WO_FIN, scr, r, lane); continue; } r -= I2;
        transpose_item(wf_out, FF, D, WB + WO_FOUT, scr, r, lane);
    }
}

__device__ __forceinline__ void ph_normmod(const Params& P, int layer) {
    const int tid = tid_fresh(), lane = tid & 63, wave = tid >> 6;
    const int gw = bid_fresh() * NWAVES + wave, NGW = grid_fresh() * NWAVES;
    bf16* H = (bf16*)(P.ws + WS_H);
    const float* ng = P.in[6] + (size_t)(layer * 4 + 0) * D;
    for (int r = gw; r < R; r += NGW) {
        const float4* xr = (const float4*)xrow(P, r) + lane;
        float4 v[4]; float ss = 0.f;
#pragma unroll
        for (int j = 0; j < 4; ++j) { v[j] = xr[64 * j]; ss += (v[j].x * v[j].x + v[j].y * v[j].y) + (v[j].z * v[j].z + v[j].w * v[j].w); }
        const float rs = 1.f / sqrtf(wave_sum(ss) * (1.f / D) + EPS);
        const int set = modset(r); const float* sh = modp(P, layer, set, 0); const float* sc = modp(P, layer, set, 1);
#pragma unroll
        for (int j = 0; j < 4; ++j) { const int col = 4 * lane + 256 * j;
            const float4 g4 = *(const float4*)(ng + col), sh4 = *(const float4*)(sh + col), sc4 = *(const float4*)(sc + col);
            const float o0 = v[j].x * rs * g4.x * (1.f + sc4.x) + sh4.x, o1 = v[j].y * rs * g4.y * (1.f + sc4.y) + sh4.y;
            const float o2 = v[j].z * rs * g4.z * (1.f + sc4.z) + sh4.z, o3 = v[j].w * rs * g4.w * (1.f + sc4.w) + sh4.w;
            uint2 w; w.x = pk2(o0, o1); w.y = pk2(o2, o3); *(uint2*)(H + (size_t)r * D + col) = w; }
    }
}
__device__ __forceinline__ void ph_resid(const Params& P, int layer, int stage, const float* Y) {
    const int tid = tid_fresh(), lane = tid & 63, wave = tid >> 6;
    const int gw = bid_fresh() * NWAVES + wave, NGW = grid_fresh() * NWAVES;
    bf16* H = (bf16*)(P.ws + WS_H);
    const float* ngA = P.in[6] + (size_t)(layer * 4 + (stage == 1 ? 1 : 3)) * D;
    const float* ngB = P.in[6] + (size_t)(layer * 4 + 2) * D;
    const int rmax = (layer == DEPTH - 1) ? RL : R;
    for (int r = gw; r < rmax; r += NGW) {
        const float4* yr = (const float4*)(Y + (size_t)r * D) + lane; float4* xr = (float4*)xrow(P, r) + lane;
        float4 y[4]; float ss = 0.f;
#pragma unroll
        for (int j = 0; j < 4; ++j) { y[j] = yr[64 * j]; ss += (y[j].x * y[j].x + y[j].y * y[j].y) + (y[j].z * y[j].z + y[j].w * y[j].w); }
        const float rsy = 1.f / sqrtf(wave_sum(ss) * (1.f / D) + EPS);
        const int set = modset(r); const float* gate = modp(P, layer, set, stage == 1 ? 2 : 5);
        float4 x[4]; float sx = 0.f;
#pragma unroll
        for (int j = 0; j < 4; ++j) { const int col = 4 * lane + 256 * j; const float4 g4 = *(const float4*)(ngA + col), gt = *(const float4*)(gate + col); float4 xv = xr[64 * j];
            xv.x += gt.x * (y[j].x * rsy * g4.x); xv.y += gt.y * (y[j].y * rsy * g4.y); xv.z += gt.z * (y[j].z * rsy * g4.z); xv.w += gt.w * (y[j].w * rsy * g4.w);
            x[j] = xv; xr[64 * j] = xv; sx += (xv.x * xv.x + xv.y * xv.y) + (xv.z * xv.z + xv.w * xv.w); }
        if (stage == 1) {
            const float rs = 1.f / sqrtf(wave_sum(sx) * (1.f / D) + EPS);
            const float* sh = modp(P, layer, set, 3); const float* sc = modp(P, layer, set, 4);
#pragma unroll
            for (int j = 0; j < 4; ++j) { const int col = 4 * lane + 256 * j;
                const float4 g4 = *(const float4*)(ngB + col), sh4 = *(const float4*)(sh + col), sc4 = *(const float4*)(sc + col);
                const float o0 = x[j].x * rs * g4.x * (1.f + sc4.x) + sh4.x, o1 = x[j].y * rs * g4.y * (1.f + sc4.y) + sh4.y;
                const float o2 = x[j].z * rs * g4.z * (1.f + sc4.z) + sh4.z, o3 = x[j].w * rs * g4.w * (1.f + sc4.w) + sh4.w;
                uint2 w; w.x = pk2(o0, o1); w.y = pk2(o2, o3); *(uint2*)(H + (size_t)r * D + col) = w; }
        }
    }
}

__device__ __forceinline__ void ph_attn(const Params& P, int layer, unsigned char* lds) {
    const int tid = tid_fresh(), lane = tid & 63, wave = tid >> 6;
    const int gw = bid_fresh() * NWAVES + wave, NGW = grid_fresh() * NWAVES;
    const bf16* QKV = (const bf16*)(P.ws + WS_BIG1); bf16* O = (bf16*)(P.ws + WS_BIG2);
    const float* rpb = P.in[8] + (size_t)(layer >> 1) * 8 * 15 * 31;
    float* pw = (float*)lds + wave * 384;
    for (int task = gw; task < R * 8; task += NGW) {
        const int row = task >> 3, h = task & 7;
        const bool isctx = row >= RL;
        int b, qr = 0, qc = 0, r0 = 0, c0 = 0;
        if (!isctx) { b = row / T; const int t = row % T; qr = t >> 6; qc = t & 63; r0 = min(max(qr - 4, 0), 120); c0 = min(max(qc - 8, 0), 48); }
        else b = (row - RL) / LC;
        const int ctxbase = RL + b * LC;
        unsigned q[32];
        { const uint4* qp = (const uint4*)(QKV + (size_t)row * HYB_IN + h * 64);
#pragma unroll
          for (int i = 0; i < 8; ++i) { const uint4 w = qp[i]; q[4 * i + 0] = w.x; q[4 * i + 1] = w.y; q[4 * i + 2] = w.z; q[4 * i + 3] = w.w; } }
        const int nk = isctx ? 256 : 384;
        float sc[6]; float mx = -3.0e38f;
#pragma unroll
        for (int jj = 0; jj < 6; ++jj) {
            const int kk = lane + 64 * jj; float s = -3.0e38f;
            if (kk < nk) {
                int krow; float bias = 0.f;
                if (!isctx && kk < 128) { const int gr = r0 + (kk >> 4), gc = c0 + (kk & 15); krow = b * T + gr * 64 + gc;
                    const int dc = min(max(gc - qc, -15), 15) + 15; bias = rpb[h * 465 + (gr - qr + 7) * 31 + dc]; }
                else krow = ctxbase + (isctx ? kk : kk - 128);
                const uint4* kp = (const uint4*)(QKV + (size_t)krow * HYB_IN + 512 + h * 64);
                float dot = 0.f;
#pragma unroll
                for (int i = 0; i < 8; ++i) { const uint4 w = kp[i];
                    dot += bflo(q[4 * i + 0]) * bflo(w.x) + bfhi(q[4 * i + 0]) * bfhi(w.x) + bflo(q[4 * i + 1]) * bflo(w.y) + bfhi(q[4 * i + 1]) * bfhi(w.y)
                         + bflo(q[4 * i + 2]) * bflo(w.z) + bfhi(q[4 * i + 2]) * bfhi(w.z) + bflo(q[4 * i + 3]) * bflo(w.w) + bfhi(q[4 * i + 3]) * bfhi(w.w); }
                s = dot * 0.125f + bias;
            }
            asm volatile("" : "+v"(s) :: "memory");
            sc[jj] = s; mx = fmaxf(mx, s);
        }
        mx = wave_max(mx);
        float sum = 0.f;
#pragma unroll
        for (int jj = 0; jj < 6; ++jj) { const int kk = lane + 64 * jj; const float e = (kk < nk) ? __expf(sc[jj] - mx) : 0.f; sc[jj] = e; sum += e; }
        sum = wave_sum(sum); const float inv = 1.f / sum;
        asm volatile("s_waitcnt lgkmcnt(0)" ::: "memory"); __builtin_amdgcn_wave_barrier();
#pragma unroll
        for (int jj = 0; jj < 6; ++jj) { const int kk = lane + 64 * jj; if (kk < nk) pw[kk] = sc[jj] * inv; }
        asm volatile("s_waitcnt lgkmcnt(0)" ::: "memory"); __builtin_amdgcn_wave_barrier();
        float acc = 0.f;
        const bf16* Vb = QKV + 1024 + h * 64 + lane;
        if (!isctx) {
            for (int kk = 0; kk < 128; ++kk) { const int krow = b * T + (r0 + (kk >> 4)) * 64 + c0 + (kk & 15); acc += pw[kk] * bf2f(Vb[(size_t)krow * HYB_IN]); }
            for (int kk = 0; kk < 256; ++kk) acc += pw[128 + kk] * bf2f(Vb[(size_t)(ctxbase + kk) * HYB_IN]);
        } else {
            for (int kk = 0; kk < 256; ++kk) acc += pw[kk] * bf2f(Vb[(size_t)(ctxbase + kk) * HYB_IN]);
        }
        O[(size_t)row * D + h * 64 + lane] = (bf16)f2bf(acc);
    }
}

__device__ __forceinline__ void ph_sgu(const Params& P, int layer, unsigned char* lds) {
    const int tid = tid_fresh();
    const bf16* QKV = (const bf16*)(P.ws + WS_BIG1); bf16* O = (bf16*)(P.ws + WS_BIG2);
    const int j = layer >> 1;
    float* vn = (float*)lds;
    float* st = vn + 128 * 64;
    float* part = st + 256;
    for (int u = bid_fresh(); u < (R / 128) * 8; u += grid_fresh()) {
        const int ch = u >> 3, g = u & 7; const int row0 = ch * 128;
        {
            const int p = tid >> 2, qd = tid & 3; const bf16* gp = QKV + (size_t)(row0 + p) * HYB_IN + 2048 + qd * 128;
            float s = 0.f, s2 = 0.f;
            for (int c = 0; c < 128; ++c) { const float v = gelu_f(bf2f(gp[c])); s += v; s2 += v * v; }
            part[tid * 2] = s; part[tid * 2 + 1] = s2;
        }
        __syncthreads();
        if (tid < 128) { float s = 0.f, s2 = 0.f;
            for (int qd = 0; qd < 4; ++qd) { s += part[(tid * 4 + qd) * 2]; s2 += part[(tid * 4 + qd) * 2 + 1]; }
            const float mu = s * (1.f / 512.f); float var = s2 * (1.f / 512.f) - mu * mu; var = fmaxf(var, 0.f);
            st[tid * 2] = mu; st[tid * 2 + 1] = 1.f / sqrtf(var + EPS); }
        __syncthreads();
        for (int i = tid; i < 128 * 64; i += NTHR) { const int p = i >> 6, c = i & 63;
            const float v = gelu_f(bf2f(QKV[(size_t)(row0 + p) * HYB_IN + 2048 + g * 64 + c])); vn[i] = (v - st[p * 2]) * st[p * 2 + 1]; }
        __syncthreads();
        {
            const int c = tid & 63, pg = tid >> 6;
            const float* ws = P.in[9] + ((size_t)(j * 8 + g) * 128) * 128; const float* bs = P.in[10] + (size_t)(j * 8 + g) * 128;
            float acc[16];
#pragma unroll
            for (int i = 0; i < 16; ++i) acc[i] = 0.f;
            for (int q = 0; q < 128; ++q) { const float v = vn[q * 64 + c];
#pragma unroll
                for (int i = 0; i < 16; ++i) acc[i] += ws[(size_t)(pg * 16 + i) * 128 + q] * v; }
#pragma unroll
            for (int i = 0; i < 16; ++i) { const int p = pg * 16 + i; const float uu = gelu_f(bf2f(QKV[(size_t)(row0 + p) * HYB_IN + 1536 + g * 64 + c]));
                O[(size_t)(row0 + p) * D + 512 + g * 64 + c] = (bf16)f2bf(uu * (acc[i] + bs[p])); }
        }
        __syncthreads();
    }
}

typedef short v4i16_t __attribute__((ext_vector_type(4)));
__device__ __forceinline__ v4i16_t ds_tr16(LAS const unsigned char* p) { return __builtin_amdgcn_ds_read_tr16_b64_v4i16((LAS v4i16_t*)p); }
__device__ __forceinline__ bf16x8 cat8(v4i16_t lo, v4i16_t hi) { return (bf16x8){lo[0], lo[1], lo[2], lo[3], hi[0], hi[1], hi[2], hi[3]}; }
__device__ __forceinline__ f32x4 mfma16(bf16x8 a, bf16x8 b, f32x4 c) { return __builtin_amdgcn_mfma_f32_16x16x32_bf16(a, b, c, 0, 0, 0); }
__device__ __forceinline__ size_t st_slot(int dir, int b, int h, int idx) { return ((size_t)(((dir * 2 + b) * 8 + h) * 66 + idx)) * 32768; }
constexpr float LOG2E = 1.4426950408889634f;

__device__ __forceinline__ void ph_ret_kv(const Params& P, int layer, LAS unsigned char* lds) {
    const int tid = tid_fresh(), lane = tid & 63, w = __builtin_amdgcn_readfirstlane(tid >> 6), l15 = lane & 15, g = lane >> 4, q4 = (lane & 15) >> 2, p4 = lane & 3;
    const bf16* QKVG = (const bf16*)(P.ws + WS_BIG1); bf16* ST = (bf16*)(P.ws + WS_ST);
    const int j = layer >> 1;
    constexpr int KF = 0, KB = 34816, VS = 69632;
    for (int u = bid_fresh(); u < 16 * 66; u += grid_fresh()) {
        const int idx = u % 66, bh = u / 66, b = bh >> 3, h = bh & 7;
        const int row0 = idx < 2 ? RL + b * LC + 128 * idx : b * T + 128 * (idx - 2);
        const float l2f = P.in[13][(j * 2 + 0) * 8 + h] * LOG2E, l2b = P.in[13][(j * 2 + 1) * 8 + h] * LOG2E;
        __syncthreads();
        {
            const int r = tid >> 2, qd = tid & 3;
            const v4u* kp = (const v4u*)(QKVG + (size_t)(row0 + r) * RET_IN + 1024 + h * 128 + qd * 32);
            const float wf = __builtin_amdgcn_exp2f(l2f * (float)(127 - r)), wb = __builtin_amdgcn_exp2f(l2b * (float)r);
#pragma unroll
            for (int i = 0; i < 4; ++i) { const v4u kv = kp[i]; v4u of, ob;
                of.x = pk2(bflo(kv.x) * wf, bfhi(kv.x) * wf); of.y = pk2(bflo(kv.y) * wf, bfhi(kv.y) * wf); of.z = pk2(bflo(kv.z) * wf, bfhi(kv.z) * wf); of.w = pk2(bflo(kv.w) * wf, bfhi(kv.w) * wf);
                ob.x = pk2(bflo(kv.x) * wb, bfhi(kv.x) * wb); ob.y = pk2(bflo(kv.y) * wb, bfhi(kv.y) * wb); ob.z = pk2(bflo(kv.z) * wb, bfhi(kv.z) * wb); ob.w = pk2(bflo(kv.w) * wb, bfhi(kv.w) * wb);
                *(LAS v4u*)(lds + KF + r * 272 + qd * 64 + i * 16) = of; *(LAS v4u*)(lds + KB + r * 272 + qd * 64 + i * 16) = ob; }
            const v4u* vp = (const v4u*)(QKVG + (size_t)(row0 + r) * RET_IN + 2048 + h * 256 + qd * 64);
#pragma unroll
            for (int i = 0; i < 8; ++i) *(LAS v4u*)(lds + VS + r * 528 + qd * 128 + i * 16) = vp[i];
        }
        __syncthreads();
        float zf = 0.f; asm volatile("" : "+v"(zf)); const f32x4 zero4 = (f32x4){zf, zf, zf, zf};
        f32x4 af[16], ab[16];
#pragma unroll
        for (int c = 0; c < 16; ++c) { af[c] = zero4; ab[c] = zero4; }
#pragma unroll
        for (int ks = 0; ks < 4; ++ks) {
            const int ra = 32 * ks + 8 * g + q4;
            LAS const unsigned char* pa = lds + KF + ra * 272 + (16 * w + 4 * p4) * 2;
            const bf16x8 aF = cat8(ds_tr16(pa), ds_tr16(pa + 4 * 272));
            LAS const unsigned char* pb = lds + KB + ra * 272 + (16 * w + 4 * p4) * 2;
            const bf16x8 aB = cat8(ds_tr16(pb), ds_tr16(pb + 4 * 272));
#pragma unroll
            for (int c = 0; c < 16; ++c) {
                LAS const unsigned char* pv = lds + VS + ra * 528 + (16 * c + 4 * p4) * 2;
                const bf16x8 bv = cat8(ds_tr16(pv), ds_tr16(pv + 4 * 528));
                af[c] = mfma16(aF, bv, af[c]); ab[c] = mfma16(aB, bv, ab[c]);
            }
        }
        bf16* sf = ST + st_slot(0, b, h, idx) + (size_t)(16 * w + 4 * g) * 256 + l15; bf16* sb = ST + st_slot(1, b, h, idx) + (size_t)(16 * w + 4 * g) * 256 + l15;
#pragma unroll
        for (int c = 0; c < 16; ++c)
#pragma unroll
            for (int rg = 0; rg < 4; ++rg) { sf[rg * 256 + 16 * c] = (bf16)f2bf(af[c][rg]); sb[rg * 256 + 16 * c] = (bf16)f2bf(ab[c][rg]); }
    }
}
__device__ __forceinline__ void ph_ret_scan(const Params& P, int layer) {
    const int tid = tid_fresh();
    bf16* ST = (bf16*)(P.ws + WS_ST);
    for (int id = bid_fresh() * NTHR + tid; id < 32 * 4096; id += grid_fresh() * NTHR) {
        const int stream = id >> 12, off = (id & 4095) * 8, dir = stream >> 4, h = stream & 7;
        const float gC = expf(P.in[13][((layer >> 1) * 2 + dir) * 8 + h] * 128.f);
        bf16* base = ST + (size_t)stream * 66 * 32768 + off;
        float S[8];
#pragma unroll
        for (int k = 0; k < 8; ++k) { float zf = 0.f; asm volatile("" : "+v"(zf)); S[k] = zf; }
        for (int s0 = 0; s0 < 66; s0 += 6) {
            uint4 v[6];
#pragma unroll
            for (int uu = 0; uu < 6; ++uu) { const int sidx = s0 + uu; const int idx = dir ? (sidx < 2 ? 1 - sidx : 67 - sidx) : sidx; v[uu] = *(const uint4*)(base + (size_t)idx * 32768); }
#pragma unroll
            for (int uu = 0; uu < 6; ++uu) { const int sidx = s0 + uu; const int idx = dir ? (sidx < 2 ? 1 - sidx : 67 - sidx) : sidx;
                uint4 o; o.x = pk2(S[0], S[1]); o.y = pk2(S[2], S[3]); o.z = pk2(S[4], S[5]); o.w = pk2(S[6], S[7]);
                *(uint4*)(base + (size_t)idx * 32768) = o;
                S[0] = gC * S[0] + bflo(v[uu].x); S[1] = gC * S[1] + bfhi(v[uu].x); S[2] = gC * S[2] + bflo(v[uu].y); S[3] = gC * S[3] + bfhi(v[uu].y);
                S[4] = gC * S[4] + bflo(v[uu].z); S[5] = gC * S[5] + bfhi(v[uu].z); S[6] = gC * S[6] + bflo(v[uu].w); S[7] = gC * S[7] + bfhi(v[uu].w); }
        }
    }
}
__device__ __forceinline__ void ph_ret_out(const Params& P, int layer, LAS unsigned char* lds) {
    const int tid = tid_fresh(), lane = tid & 63, w = __builtin_amdgcn_readfirstlane(tid >> 6), l15 = lane & 15, g = lane >> 4, q4 = (lane & 15) >> 2, p4 = lane & 3;
    bf16* QKVG = (bf16*)(P.ws + WS_BIG1); const bf16* ST = (const bf16*)(P.ws + WS_ST);
    const int j = layer >> 1; const bool lastl = layer == DEPTH - 1;
    const float* gn = P.in[14] + (size_t)j * 2048;
    constexpr int QS = 0, KS = 34816, SL = 69632;
    for (int u = bid_fresh(); u < 16 * 66; u += grid_fresh()) {
        const int idx = u % 66, bh = u / 66, b = bh >> 3, h = bh & 7;
        if (lastl && idx < 2) continue;
        const int row0 = idx < 2 ? RL + b * LC + 128 * idx : b * T + 128 * (idx - 2);
        const float l2f = P.in[13][(j * 2 + 0) * 8 + h] * LOG2E, l2b = P.in[13][(j * 2 + 1) * 8 + h] * LOG2E;
        __syncthreads();
        {
            const int r = tid >> 2, qd = tid & 3;
            const v4u* qp = (const v4u*)(QKVG + (size_t)(row0 + r) * RET_IN + h * 128 + qd * 32);
            const v4u* kp = (const v4u*)(QKVG + (size_t)(row0 + r) * RET_IN + 1024 + h * 128 + qd * 32);
#pragma unroll
            for (int i = 0; i < 4; ++i) { *(LAS v4u*)(lds + QS + r * 272 + qd * 64 + i * 16) = qp[i]; *(LAS v4u*)(lds + KS + r * 272 + qd * 64 + i * 16) = kp[i]; }
        }
        __syncthreads();
        bf16x8 qf[4];
#pragma unroll
        for (int ks = 0; ks < 4; ++ks) qf[ks] = *(LAS const bf16x8*)(lds + QS + (16 * w + l15) * 272 + (32 * ks + 8 * g) * 2);
        float zf = 0.f; asm volatile("" : "+v"(zf)); const f32x4 zero4 = (f32x4){zf, zf, zf, zf};
        f32x4 pacc[8];
#pragma unroll
        for (int kt = 0; kt < 8; ++kt) { pacc[kt] = zero4;
#pragma unroll
            for (int ks = 0; ks < 4; ++ks) { const bf16x8 kf = *(LAS const bf16x8*)(lds + KS + (16 * kt + l15) * 272 + (32 * ks + 8 * g) * 2); pacc[kt] = mfma16(kf, qf[ks], pacc[kt]); } }
        const int qi = 16 * w + l15;
        bf16x8 pf[4];
#pragma unroll
        for (int sx = 0; sx < 4; ++sx) { unsigned pk[4];
#pragma unroll
            for (int e2 = 0; e2 < 4; ++e2) { float vv[2];
#pragma unroll
                for (int z = 0; z < 2; ++z) { const int e = 2 * e2 + z; const int kt = 2 * sx + (e >> 2), rg = e & 3; const int key = 16 * kt + 4 * g + rg; const int df = qi - key;
                    const float dec = df > 0 ? __builtin_amdgcn_exp2f(l2f * (float)df) : (df < 0 ? __builtin_amdgcn_exp2f(-l2b * (float)df) : 2.f);
                    vv[z] = pacc[kt][rg] * dec; }
                pk[e2] = pk2(vv[0], vv[1]); }
            pf[sx] = __builtin_bit_cast(bf16x8, (v4u){pk[0], pk[1], pk[2], pk[3]}); }
        const float dqf = __builtin_amdgcn_exp2f(l2f * (float)(qi + 1)), dqb = __builtin_amdgcn_exp2f(l2b * (float)(128 - qi));
        f32x4 acc[16];
#pragma unroll
        for (int c = 0; c < 16; ++c) acc[c] = zero4;
        const bf16* sfp = ST + st_slot(0, b, h, idx); const bf16* sbp = ST + st_slot(1, b, h, idx);
#pragma unroll
        for (int sl = 0; sl < 6; ++sl) {
            __syncthreads();
            {
                const int r = tid >> 3, pc = tid & 7;
                const v4u* src = sl < 2 ? (const v4u*)(QKVG + (size_t)(row0 + 64 * sl + r) * RET_IN + 2048 + h * 256 + pc * 32)
                                 : (sl < 4 ? (const v4u*)(sfp + (size_t)(64 * (sl - 2) + r) * 256 + pc * 32) : (const v4u*)(sbp + (size_t)(64 * (sl - 4) + r) * 256 + pc * 32));
#pragma unroll
                for (int i = 0; i < 4; ++i) *(LAS v4u*)(lds + SL + r * 528 + pc * 64 + i * 16) = src[i];
            }
            __syncthreads();
#pragma unroll
            for (int k2 = 0; k2 < 2; ++k2) {
                bf16x8 a;
                if (sl < 2) a = pf[2 * sl + k2];
                else { const float dq = sl < 4 ? dqf : dqb; const v4u qu = __builtin_bit_cast(v4u, qf[2 * ((sl - 2) & 1) + k2]); v4u t;
                    t.x = pk2(bflo(qu.x) * dq, bfhi(qu.x) * dq); t.y = pk2(bflo(qu.y) * dq, bfhi(qu.y) * dq); t.z = pk2(bflo(qu.z) * dq, bfhi(qu.z) * dq); t.w = pk2(bflo(qu.w) * dq, bfhi(qu.w) * dq);
                    a = __builtin_bit_cast(bf16x8, t); }
                const int r0 = sl < 2 ? 32 * k2 + 4 * g + q4 : 32 * k2 + 8 * g + q4, rstep = sl < 2 ? 16 : 4;
#pragma unroll
                for (int c = 0; c < 16; ++c) {
                    LAS const unsigned char* pv = lds + SL + r0 * 528 + (16 * c + 4 * p4) * 2;
                    const bf16x8 bv = cat8(ds_tr16(pv), ds_tr16(pv + rstep * 528));
                    acc[c] = mfma16(a, bv, acc[c]);
                    if ((c & 3) == 3) __builtin_amdgcn_sched_barrier(0);
                }
            }
        }
        float mu[4], rs[4];
#pragma unroll
        for (int rg = 0; rg < 4; ++rg) { float sm = 0.f;
#pragma unroll
            for (int c = 0; c < 16; ++c) sm += acc[c][rg];
            sm += __shfl_xor(sm, 1); sm += __shfl_xor(sm, 2); sm += __shfl_xor(sm, 4); sm += __shfl_xor(sm, 8); mu[rg] = sm * (1.f / 256.f);
            float qv = 0.f;
#pragma unroll
            for (int c = 0; c < 16; ++c) { const float dlt = acc[c][rg] - mu[rg]; qv += dlt * dlt; }
            qv += __shfl_xor(qv, 1); qv += __shfl_xor(qv, 2); qv += __shfl_xor(qv, 4); qv += __shfl_xor(qv, 8); rs[rg] = 1.f / sqrtf(qv * (1.f / 256.f) + EPS); }
#pragma unroll
        for (int rg = 0; rg < 4; ++rg) { bf16* rp = QKVG + (size_t)(row0 + 16 * w + 4 * g + rg) * RET_IN;
#pragma unroll
            for (int c = 0; c < 16; ++c) { const int col = h * 256 + 16 * c + l15; const float gg = bf2f(rp[4096 + col]);
                rp[2048 + col] = (bf16)f2bf(gg * ((acc[c][rg] - mu[rg]) * rs[rg] * gn[col])); } }
    }
}

__device__ __forceinline__ void ph_conv(const Params& P, int layer) {
    const bf16* A = (const bf16*)(P.ws + WS_BIG1); bf16* O = (bf16*)(P.ws + WS_BIG2);
    const float* cw = P.in[17] + (size_t)layer * 3 * FF2; const float* cb = P.in[18] + (size_t)layer * FF2;
    const size_t nit = (size_t)R * (FF / 8);
    for (size_t it = (size_t)bid_fresh() * NTHR + tid_fresh(); it < nit; it += (size_t)grid_fresh() * NTHR) {
        const int r = (int)(it / (FF / 8)), c0 = (int)(it % (FF / 8)) * 8;
        int s, len; if (r < RL) { s = r % T; len = T; } else { s = (r - RL) % LC; len = LC; }
        const bool hp = s > 0, hn = s < len - 1;
        float res[8];
#pragma unroll
        for (int half = 0; half < 2; ++half) {
            const int c = c0 + half * FF;
            const uint4 z = make_uint4(0u, 0u, 0u, 0u);
            const uint4 am = hp ? *(const uint4*)(A + (size_t)(r - 1) * FF2 + c) : z;
            const uint4 a0 = *(const uint4*)(A + (size_t)r * FF2 + c);
            const uint4 ap = hn ? *(const uint4*)(A + (size_t)(r + 1) * FF2 + c) : z;
            const unsigned um[4] = {am.x, am.y, am.z, am.w}, u0[4] = {a0.x, a0.y, a0.z, a0.w}, up[4] = {ap.x, ap.y, ap.z, ap.w};
#pragma unroll
            for (int e = 0; e < 8; ++e) {
                const float vm = (e & 1) ? bfhi(um[e >> 1]) : bflo(um[e >> 1]), v0 = (e & 1) ? bfhi(u0[e >> 1]) : bflo(u0[e >> 1]), vp = (e & 1) ? bfhi(up[e >> 1]) : bflo(up[e >> 1]);
                const float cv = cw[c + e] * vm + cw[FF2 + c + e] * v0 + cw[2 * FF2 + c + e] * vp + cb[c + e];
                if (half == 0) res[e] = silu_f(cv); else res[e] *= cv;
            }
        }
        uint4 w; w.x = pk2(res[0], res[1]); w.y = pk2(res[2], res[3]); w.z = pk2(res[4], res[5]); w.w = pk2(res[6], res[7]);
        *(uint4*)(O + (size_t)r * FF + c0) = w;
    }
}

__device__ __forceinline__ void ph_gemm_bf16(LAS unsigned char* lds, const bf16* A, int lda, const bf16* Bt, bf16* O, int N, int K) {
    pg8::Gemm g{A, Bt, R, N, K, lda}; pg8::StaticOrder S; S.init(R, N, (int)grid_fresh(), (int)bid_fresh());
    pg8::EpiBf16<0> E{O, N, nullptr, 0, 0, 1.f};
    pg8::gemm_phase<pg8::EpiBf16<0>, pg8::StaticOrder, true, true>(lds, g, S, E);
}
__device__ __forceinline__ void ph_gemm_f32(LAS unsigned char* lds, const bf16* A, int lda, const bf16* Bt, float* C, int N, int K) {
    pg8::Gemm g{A, Bt, R, N, K, lda}; pg8::StaticOrder S; S.init(R, N, (int)grid_fresh(), (int)bid_fresh());
    pg8::EpiF32 E{C, N, nullptr};
    pg8::gemm_phase<pg8::EpiF32, pg8::StaticOrder, true, true>(lds, g, S, E);
}

__device__ __forceinline__ void ph_gemm_ret(LAS unsigned char* lds, const bf16* A, const bf16* Bt, bf16* O, const float* tab) {
    pg8::Gemm g{A, Bt, R, RET_IN, D, D}; pg8::StaticOrder S; S.init(R, RET_IN, (int)grid_fresh(), (int)bid_fresh());
    pg8::EpiRet E{O, tab};
    pg8::gemm_phase<pg8::EpiRet, pg8::StaticOrder, true, true>(lds, g, S, E);
}
__global__ void __launch_bounds__(NTHR, 2) fwd_kernel(Params P) {
    extern __shared__ __attribute__((aligned(16))) unsigned char lds[];
    LAS unsigned char* ldsl = (LAS unsigned char*)lds;
    const int tid = tid_fresh();
    gu32* ctl = (gu32*)(P.ws + WS_CTL);
#if ONE_LAUNCH
    for (int u = tid; u < (LDS_BYTES - LDSCTL_OFF) / 4; u += NTHR) ((LAS unsigned*)(ldsl + LDSCTL_OFF))[u] = 0u;
    __syncthreads();
    (void)xcd_barrier_post((unsigned*)(ctl + CW_BAR), (volatile LAS unsigned*)(ldsl + MISC_OFF) + 8);
#endif
    const int ph_lo = P.ph_lo, ph_hi = P.ph_hi;
    enum { OP_WN, OP_GIN, OP_MIXE, OP_KV, OP_SCAN, OP_RETOUT, OP_GOUT, OP_RES1, OP_FIN, OP_CONV, OP_FOUT, OP_RES2 };
    for (int ph = ph_lo; ph < ph_hi; ++ph) {
        unsigned char* wsb = P.ws;
        bf16* WB = (bf16*)(wsb + WS_W); bf16* H = (bf16*)(wsb + WS_H); bf16* B1 = (bf16*)(wsb + WS_BIG1); bf16* B2 = (bf16*)(wsb + WS_BIG2);
        if (ph == 0) { ph_init(P, lds); }
        else {
            const int p = ph - 1; int layer, st;
            if (p < 9) { layer = 0; st = p; } else if (p < 20) { layer = 1; st = p - 9; } else if (p < 29) { layer = 2; st = p - 20; } else { layer = 3; st = p - 29; }
            const bool even = (layer & 1) == 0;
            int op;
            if (even) op = st == 0 ? OP_WN : st == 1 ? OP_GIN : st == 2 ? OP_MIXE : st == 3 ? OP_GOUT : st == 4 ? OP_RES1 : st == 5 ? OP_FIN : st == 6 ? OP_CONV : st == 7 ? OP_FOUT : OP_RES2;
            else op = st == 0 ? OP_WN : st == 1 ? OP_GIN : st == 2 ? OP_KV : st == 3 ? OP_SCAN : st == 4 ? OP_RETOUT : st == 5 ? OP_GOUT : st == 6 ? OP_RES1 : st == 7 ? OP_FIN : st == 8 ? OP_CONV : st == 9 ? OP_FOUT : OP_RES2;
            if ((op == OP_GIN && even) || op == OP_FIN) ph_gemm_bf16(ldsl, H, D, WB + (op == OP_GIN ? WO_IN : WO_FIN), B1, op == OP_GIN ? HYB_IN : FF2, D);
            else if ((PHMASK & 4) && op == OP_GIN) ph_gemm_ret(ldsl, H, WB + WO_IN, B1, (const float*)(wsb + WS_ROPE));
            else if (op == OP_GOUT || op == OP_FOUT) {
                const bool ro = (op == OP_GOUT) && !even;
                ph_gemm_f32(ldsl, ro ? B1 + 2048 : B2, ro ? RET_IN : (op == OP_GOUT ? D : FF), WB + (op == OP_GOUT ? WO_OUT : WO_FOUT), ro ? (float*)B2 : (float*)B1, D, op == OP_GOUT ? (even ? D : 2048) : FF);
            }
            else if (op == OP_WN) { ph_wconv(P, layer, ldsl); ph_normmod(P, layer); }
            else if (op == OP_MIXE) { ph_attn(P, layer, lds); __syncthreads(); ph_sgu(P, layer, lds); }
            else if ((PHMASK & 1) && op == OP_KV) ph_ret_kv(P, layer, ldsl);
            else if (op == OP_SCAN) ph_ret_scan(P, layer);
            else if ((PHMASK & 2) && op == OP_RETOUT) ph_ret_out(P, layer, ldsl);
            else if (op == OP_RES1) ph_resid(P, layer, 1, (!even) ? (const float*)B2 : (const float*)B1);
            else if (op == OP_CONV) ph_conv(P, layer);
            else ph_resid(P, layer, 2, (const float*)B1);
        }
#if ONE_LAUNCH
        if (ph + 1 < ph_hi) {
            XcdBarrier bar; bar.bar = (unsigned*)((gu32*)(P.ws + WS_CTL) + CW_BAR); bar.x = xb_xcc_id(); bar.st = (volatile LAS unsigned*)(ldsl + MISC_OFF) + 8;
            xcd_barrier(bar); }
#endif
    }
}

extern "C" void kernel_launch(void* const* d_in, const int* in_sizes, int n_in, void* d_out, int out_size, void* d_ws, size_t ws_size, hipStream_t stream) {
    static int grid = 0;
    if (grid == 0) {
        if (n_in != 20 || out_size != RL * D || ws_size < WS_END) { fprintf(stderr, "kernel_launch: unexpected shapes (n_in %d out %d ws %zu)\n", n_in, out_size, ws_size); grid = -1; return; }
        int dev = 0, cus = 0;
        if (hipGetDevice(&dev) != hipSuccess || hipDeviceGetAttribute(&cus, hipDeviceAttributeMultiprocessorCount, dev) != hipSuccess) { grid = -1; return; }
        if (hipFuncSetAttribute((const void*)fwd_kernel, hipFuncAttributeMaxDynamicSharedMemorySize, LDS_BYTES) != hipSuccess) { grid = -1; return; }
        grid = cus;
    }
    if (grid < 0) return;
    (void)hipMemsetAsync((char*)d_ws + WS_CTL, 0, CTL_ZERO_BYTES, stream);
    Params p{};
    for (int i = 0; i < 20; ++i) p.in[i] = (const float*)d_in[i];
    p.out = (float*)d_out; p.ws = (unsigned char*)d_ws;
#if ONE_LAUNCH
    p.ph_lo = 0; p.ph_hi = NPHASE;
    hipLaunchKernelGGL(fwd_kernel, dim3(grid), dim3(NTHR), LDS_BYTES, stream, p);
#else
    for (int ph = 0; ph < NPHASE; ++ph) { p.ph_lo = ph; p.ph_hi = ph + 1; hipLaunchKernelGGL(fwd_kernel, dim3(grid), dim3(NTHR), LDS_BYTES, stream, p); }
#endif
}
```

```cpp
#include <hip/hip_runtime.h>
#include <cstdio>
#include <cstdint>
__device__ __forceinline__ int tid_fresh() { int t = (int)threadIdx.x; asm volatile("" : "+v"(t)); return t; }
__device__ __forceinline__ int bid_fresh() { int t = (int)blockIdx.x; asm volatile("" : "+s"(t)); return t; }
__device__ __forceinline__ int grid_fresh() { int t = (int)gridDim.x; asm volatile("" : "+s"(t)); return t; }
namespace pg8 {
#define PG8_LAS __attribute__((address_space(3)))
typedef unsigned short bf16_t;
typedef short bf16x8 __attribute__((ext_vector_type(8)));
typedef float f32x4 __attribute__((ext_vector_type(4)));
typedef unsigned u32x4 __attribute__((ext_vector_type(4)));
constexpr int BM = 256, BK = 64, HALF = 128, HTB = HALF * BK * 2  , STAGE_BYTES = 8 * HTB, NXCD = 8, WGM = 8;

__host__ __device__ __forceinline__ int lds_byte(int r, int c) { const int st = (r >> 4) * 2 + (c >> 5), rr = r & 15, cc = c & 31, ob = rr * 64 + cc * 2; return st * 1024 + (ob ^ (((ob >> 9) & 1) << 5)); }
__host__ __device__ __forceinline__ void stage_rc(int b, int& R, int& C) { const int st = b / 1024, sb = b % 1024, swz = sb ^ (((sb >> 9) & 1) << 5); R = (st >> 1) * 16 + swz / 64; C = (st & 1) * 32 + (swz % 64) / 2; }
__host__ __device__ __forceinline__ int perm32(int rho) { const int n = rho >> 4, i = rho & 15; return 8 * (i >> 2) + 4 * n + (i & 3); }

struct Unit { int pm, pn; };
struct Gemm { const bf16_t* A; const bf16_t* Bt; int M, N, K, lda; };

struct StaticOrder {
    int nM, nN, nwg, G, c;
    __host__ __device__ void init(int M, int N, int G_, int c_) { nM = M / BM; nN = N / BM; nwg = nM * nN; G = G_; c = c_; }
    __host__ __device__ bool next(int i, Unit& u) const {
        const long L = (long)i * G + c; if (L >= nwg) return false;
        int wgid = (int)L; { const int q = nwg / NXCD, r = nwg % NXCD, xcd = wgid % NXCD, off = wgid / NXCD; wgid = (xcd < r ? xcd * (q + 1) : r * (q + 1) + (xcd - r) * q) + off; }
        const int nig = WGM * nN, gid = wgid / nig, fm = gid * WGM, gsz = (nM - fm) < WGM ? (nM - fm) : WGM;
        u.pm = fm + ((wgid % nig) % gsz); u.pn = (wgid % nig) / gsz; return true;
    }
    __device__ __forceinline__ void a_ready(const Unit&) const {}
    __device__ __forceinline__ void done(const Unit&) const {}
};

__device__ __forceinline__ unsigned cvt_pk_bf16(float lo, float hi) { unsigned r; asm volatile("v_cvt_pk_bf16_f32 %0, %1, %2" : "=v"(r) : "v"(lo), "v"(hi)); return r; }
typedef float f32x2 __attribute__((ext_vector_type(2)));
__device__ __forceinline__ f32x2 gelu_pk(f32x2 v) {
    const f32x2 av = __builtin_elementwise_abs(v), d = av * 0.2316418882f + 1.0f;
    f32x2 t; t.x = __builtin_amdgcn_rcpf(d.x); t.y = __builtin_amdgcn_rcpf(d.y);
    f32x2 q = t * 0.5307027145f + (-0.7265760135f); q = q * t + 0.7107068705f; q = q * t + (-0.142248368f); q = q * t + 0.127414796f; q = q * t;
    const f32x2 s = (v * v) * (-0.72134752044f);
    f32x2 e; e.x = __builtin_amdgcn_exp2f(s.x); e.y = __builtin_amdgcn_exp2f(s.y);
    const f32x2 m = v * (q * e), r = v - m;
    f32x2 o; o.x = v.x < 0.f ? m.x : r.x; o.y = v.y < 0.f ? m.y : r.y; return o;
}


struct EpiHyb {
    static constexpr bool PERM = true, AFTER_DRAIN = false;
    bf16_t* O;
    __device__ __forceinline__ void operator()(const f32x4 (&acc)[2][2][4][2], const Unit& u, int wr, int wc, int fr, int fq) const {
        const bool act = u.pn >= 6; const int col0 = u.pn * BM + wc * 32 + 8 * fq;
#pragma unroll
        for (int ai = 0; ai < 2; ++ai)
#pragma unroll
            for (int m = 0; m < 4; ++m) { bf16_t* rowp = O + (size_t)(u.pm * BM + ai * HALF + wr * 64 + m * 16 + fr) * 2560 + col0;
#pragma unroll
                for (int bj = 0; bj < 2; ++bj) { f32x4 v0 = acc[ai][bj][m][0], v1 = acc[ai][bj][m][1];
                    if (act) {
#pragma unroll
                        for (int e = 0; e < 4; ++e) { const float x0 = v0[e], x1 = v1[e];
                            v0[e] = x0 / (1.f + __expf(-1.5957691216057308f * (x0 + 0.044715f * x0 * x0 * x0)));
                            v1[e] = x1 / (1.f + __expf(-1.5957691216057308f * (x1 + 0.044715f * x1 * x1 * x1))); } }
                    u32x4 w; w.x = cvt_pk_bf16(v0[0], v0[1]); w.y = cvt_pk_bf16(v0[2], v0[3]); w.z = cvt_pk_bf16(v1[0], v1[1]); w.w = cvt_pk_bf16(v1[2], v1[3]);
                    *(u32x4*)(rowp + bj * HALF) = w; } }
    }
};
struct EpiRet {
    static constexpr bool PERM = true, AFTER_DRAIN = false;
    bf16_t* O; const float* tab;
    __device__ __forceinline__ void operator()(const f32x4 (&acc)[2][2][4][2], const Unit& u, int wr, int wc, int fr, int fq) const {
        const int pn = u.pn; const bool lat = u.pm < 64;
        if (pn < 8) {
            const float ksc = pn >= 4 ? 0.08838834764831845f : 1.f;
            const int colbase = pn * 256 + (wc >> 1) * 128 + 32 * (wc & 1) + 8 * fq;
#pragma unroll
            for (int ai = 0; ai < 2; ++ai)
#pragma unroll
                for (int m = 0; m < 4; ++m) {
                    const int row = u.pm * BM + ai * HALF + wr * 64 + m * 16 + fr;
                    f32x4 c4[2], s4[2];
                    if (lat) { const int tk = row & 8191; const int prow = (wc & 1) ? 128 + (tk & 63) : (tk >> 6); const f32x4* tp = (const f32x4*)(tab + ((size_t)prow * 32 + 8 * fq) * 2);
                        const f32x4 t0 = tp[0], t1 = tp[1], t2 = tp[2], t3 = tp[3];
                        c4[0] = (f32x4){t0[0], t0[2], t1[0], t1[2]}; s4[0] = (f32x4){t0[1], t0[3], t1[1], t1[3]};
                        c4[1] = (f32x4){t2[0], t2[2], t3[0], t3[2]}; s4[1] = (f32x4){t2[1], t2[3], t3[1], t3[3]}; }
                    else { c4[0] = c4[1] = (f32x4){1.f, 1.f, 1.f, 1.f}; s4[0] = s4[1] = (f32x4){0.f, 0.f, 0.f, 0.f}; }
                    const f32x4 a0 = acc[ai][0][m][0] * ksc, a1 = acc[ai][0][m][1] * ksc, b0 = acc[ai][1][m][0] * ksc, b1 = acc[ai][1][m][1] * ksc;
                    const f32x4 o10 = a0 * c4[0] - b0 * s4[0], o11 = a1 * c4[1] - b1 * s4[1], o20 = a0 * s4[0] + b0 * c4[0], o21 = a1 * s4[1] + b1 * c4[1];
                    u32x4 w1, w2; w1.x = cvt_pk_bf16(o10[0], o10[1]); w1.y = cvt_pk_bf16(o10[2], o10[3]); w1.z = cvt_pk_bf16(o11[0], o11[1]); w1.w = cvt_pk_bf16(o11[2], o11[3]);
                    w2.x = cvt_pk_bf16(o20[0], o20[1]); w2.y = cvt_pk_bf16(o20[2], o20[3]); w2.z = cvt_pk_bf16(o21[0], o21[1]); w2.w = cvt_pk_bf16(o21[2], o21[3]);
                    bf16_t* rp = O + (size_t)row * 6144 + colbase; *(u32x4*)rp = w1; *(u32x4*)(rp + 64) = w2;
                }
        } else {
            const bool isg = pn >= 16; const int col0 = pn * BM + wc * 32 + 8 * fq;
#pragma unroll
            for (int ai = 0; ai < 2; ++ai)
#pragma unroll
                for (int m = 0; m < 4; ++m) { bf16_t* rowp = O + (size_t)(u.pm * BM + ai * HALF + wr * 64 + m * 16 + fr) * 6144 + col0;
#pragma unroll
                    for (int bj = 0; bj < 2; ++bj) { f32x4 v0 = acc[ai][bj][m][0], v1 = acc[ai][bj][m][1];
                        if (isg) {
#pragma unroll
                            for (int e = 0; e < 4; ++e) { v0[e] = v0[e] / (1.f + __expf(-v0[e])); v1[e] = v1[e] / (1.f + __expf(-v1[e])); } }
                        u32x4 w; w.x = cvt_pk_bf16(v0[0], v0[1]); w.y = cvt_pk_bf16(v0[2], v0[3]); w.z = cvt_pk_bf16(v1[0], v1[1]); w.w = cvt_pk_bf16(v1[2], v1[3]);
                        *(u32x4*)(rowp + bj * HALF) = w; } }
        }
    }
};
template <int ACT  > struct EpiBf16 {
    static constexpr bool PERM = true, AFTER_DRAIN = false; static_assert(ACT == 0 || ACT == 1, "EpiBf16: ACT is 0 (none) or 1 (gelu_pk)");
    bf16_t* O; int ldc; const float* bias; int split_cols; size_t split_stride; float scale0;
    __device__ __forceinline__ void operator()(const f32x4 (&acc)[2][2][4][2], const Unit& u, int wr, int wc, int fr, int fq) const {
        const int row0 = u.pm * BM + wr * 64 + fr; int colt = u.pn * BM; bf16_t* base = O;
        float sc = 1.f; if (split_cols) { const int t = colt / split_cols; base += (size_t)t * split_stride; colt -= t * split_cols; if (t == 0) sc = scale0; }
        const int col0 = colt + wc * 32 + 8 * fq, bcol0 = u.pn * BM + wc * 32 + 8 * fq;
        f32x4 bv[2][2];
#pragma unroll
        for (int bj = 0; bj < 2; ++bj)
#pragma unroll
            for (int n = 0; n < 2; ++n) bv[bj][n] = bias ? *(const f32x4*)(bias + bcol0 + bj * HALF + 4 * n) : (f32x4){0.f, 0.f, 0.f, 0.f};
#pragma unroll
        for (int ai = 0; ai < 2; ++ai)
#pragma unroll
            for (int m = 0; m < 4; ++m) { bf16_t* rowp = base + (size_t)(row0 + ai * HALF + m * 16) * ldc + col0;
#pragma unroll
                for (int bj = 0; bj < 2; ++bj) { f32x4 v0 = acc[ai][bj][m][0] + bv[bj][0], v1 = acc[ai][bj][m][1] + bv[bj][1];
                    if (ACT == 1) { f32x2 a = gelu_pk((f32x2){v0[0], v0[1]}), b = gelu_pk((f32x2){v0[2], v0[3]}), c = gelu_pk((f32x2){v1[0], v1[1]}), d = gelu_pk((f32x2){v1[2], v1[3]});
                        v0 = (f32x4){a.x, a.y, b.x, b.y}; v1 = (f32x4){c.x, c.y, d.x, d.y}; }
                    v0 = v0 * sc; v1 = v1 * sc; u32x4 w; w.x = cvt_pk_bf16(v0[0], v0[1]); w.y = cvt_pk_bf16(v0[2], v0[3]); w.z = cvt_pk_bf16(v1[0], v1[1]); w.w = cvt_pk_bf16(v1[2], v1[3]);
                    *(u32x4*)(rowp + bj * HALF) = w; } }
    }
};
struct EpiF32 {
    static constexpr bool PERM = false, AFTER_DRAIN = false;
    float* C; int ldc; const float* bias;
    __device__ __forceinline__ void operator()(const f32x4 (&acc)[2][2][4][2], const Unit& u, int wr, int wc, int fr, int fq) const {
        const int row0 = u.pm * BM + wr * 64 + fr, col0 = u.pn * BM + wc * 32 + 4 * fq;
        f32x4 bv[2][2];
#pragma unroll
        for (int bj = 0; bj < 2; ++bj)
#pragma unroll
            for (int n = 0; n < 2; ++n) bv[bj][n] = bias ? *(const f32x4*)(bias + col0 + bj * HALF + n * 16) : (f32x4){0.f, 0.f, 0.f, 0.f};
#pragma unroll
        for (int ai = 0; ai < 2; ++ai)
#pragma unroll
            for (int m = 0; m < 4; ++m) { float* rowp = C + (size_t)(row0 + ai * HALF + m * 16) * ldc + col0;
#pragma unroll
                for (int bj = 0; bj < 2; ++bj)
#pragma unroll
                    for (int n = 0; n < 2; ++n) *(f32x4*)(rowp + bj * HALF + n * 16) = acc[ai][bj][m][n] + bv[bj][n]; }
    }
};
template <class Epi, class Sched, bool ALIGN_EPI = false, bool SP2 = false>
__device__ __forceinline__ void gemm_phase(PG8_LAS unsigned char* lds, const Gemm g, const Sched& S, const Epi& E) {
    const int tid = tid_fresh(), wid = __builtin_amdgcn_readfirstlane(tid >> 6), lane = tid & 63, wr = wid >> 2, wc = wid & 3, fr = lane & 15, fq = lane >> 4;
    const int K = g.K, nt = K / BK;
    unsigned voffA[2], voffB[2];
#pragma unroll
    for (int i = 0; i < 2; ++i) { int R, C; stage_rc(tid * 16 + i * 8192, R, C); const int Rb = Epi::PERM ? ((R & ~31) + perm32(R & 31)) : R;
        voffA[i] = (unsigned)(R * g.lda + C) * 2u; voffB[i] = (unsigned)(Rb * K + C) * 2u; }
    const size_t kstep = (size_t)(BK * 2);
    const size_t hstepB = (size_t)HALF * K * 2, hstepA = (size_t)HALF * g.lda * 2;
    const size_t tstepB = 2 * hstepB, tstepA = 2 * hstepA;
    const unsigned ldsw = (unsigned)wid * 1024u;
    const int aoff = lds_byte(wr * 64 + fr, fq * 8), boff = lds_byte(wc * 32 + fr, fq * 8);
#define PG8_SA(b, h) (((b) * 2 + (h)) * HTB)
#define PG8_SB(b, h) ((4 + (b) * 2 + (h)) * HTB)
#define PG8_STAGE(bufoff, gbase, voff) do { _Pragma("unroll") for (int _i = 0; _i < 2; ++_i) \
        __builtin_amdgcn_global_load_lds((const unsigned*)((const char*)(gbase) + (voff)[_i]), (PG8_LAS unsigned*)(lds + (bufoff) + ldsw + _i * 8192), 16, 0, 0); } while (0)
#define PG8_LDA(dst, b, h) do { _Pragma("unroll") for (int m = 0; m < 4; ++m) _Pragma("unroll") for (int k = 0; k < 2; ++k) dst[m][k] = *(const PG8_LAS bf16x8*)(lds + PG8_SA(b, h) + aoff + m * 2048 + k * 1024); } while (0)
#define PG8_LDB(dst, b, h) do { _Pragma("unroll") for (int n = 0; n < 2; ++n) _Pragma("unroll") for (int k = 0; k < 2; ++k) dst[n][k] = *(const PG8_LAS bf16x8*)(lds + PG8_SB(b, h) + boff + n * 2048 + k * 1024); } while (0)
#define PG8_MMA(ai, bj, At, Bt) do { __builtin_amdgcn_s_setprio(1); _Pragma("unroll") for (int m = 0; m < 4; ++m) _Pragma("unroll") for (int n = 0; n < 2; ++n) _Pragma("unroll") for (int k = 0; k < 2; ++k) \
        acc[ai][bj][m][n] = __builtin_amdgcn_mfma_f32_16x16x32_bf16(Bt[n][k], At[m][k], acc[ai][bj][m][n], 0, 0, 0); __builtin_amdgcn_s_setprio(0); } while (0)
#define PG8_WAIT_V(n) asm volatile("s_waitcnt vmcnt(" #n ")" ::: "memory")
#define PG8_WAIT_L(n) asm volatile("s_waitcnt lgkmcnt(" #n ")" ::: "memory")
#define PG8_BAR __builtin_amdgcn_s_barrier()
#define PG8_SCHED __builtin_amdgcn_sched_barrier(0)
    Unit cur, nxt; int ui = 0;
    if (!S.next(0, cur)) return;
    f32x4 acc[2][2][4][2];
#pragma unroll
    for (int a = 0; a < 2; ++a)
#pragma unroll
        for (int b = 0; b < 2; ++b)
#pragma unroll
            for (int m = 0; m < 4; ++m)
#pragma unroll
                for (int n = 0; n < 2; ++n) acc[a][b][m][n] = (f32x4){0.f, 0.f, 0.f, 0.f};
    bf16x8 At[4][2], B0[2][2], B1[2][2];
    const char* cA = (const char*)g.A + (size_t)cur.pm * tstepA; const char* cB = (const char*)g.Bt + (size_t)cur.pn * tstepB;
    S.a_ready(cur);
    if constexpr (SP2) {
        PG8_STAGE(PG8_SB(0, 0), cB, voffB); PG8_STAGE(PG8_SB(0, 1), cB + hstepB, voffB); PG8_STAGE(PG8_SA(0, 0), cA, voffA); PG8_STAGE(PG8_SA(0, 1), cA + hstepA, voffA);
        if (wr == 1) PG8_BAR;
        PG8_WAIT_V(2); PG8_BAR;
        PG8_STAGE(PG8_SB(1, 0), cB + kstep, voffB); PG8_STAGE(PG8_SA(1, 0), cA + kstep, voffA); PG8_STAGE(PG8_SB(1, 1), cB + hstepB + kstep, voffB);
        PG8_WAIT_V(6); PG8_BAR;
    } else {
        PG8_STAGE(PG8_SB(0, 0), cB, voffB); PG8_STAGE(PG8_SA(0, 0), cA, voffA); PG8_STAGE(PG8_SB(0, 1), cB + hstepB, voffB); PG8_STAGE(PG8_SA(0, 1), cA + hstepA, voffA);
        if (wr == 1) PG8_BAR;
        PG8_WAIT_V(4); PG8_BAR;
        PG8_STAGE(PG8_SB(1, 0), cB + kstep, voffB); PG8_STAGE(PG8_SA(1, 0), cA + kstep, voffA); PG8_STAGE(PG8_SB(1, 1), cB + hstepB + kstep, voffB);
        PG8_WAIT_V(6); PG8_BAR;
    }
    for (;;) {
        const bool has_next = S.next(ui + 1, nxt);
        const char* nA = has_next ? (const char*)g.A + (size_t)nxt.pm * tstepA : cA; const char* nB = has_next ? (const char*)g.Bt + (size_t)nxt.pn * tstepB : cB;
        for (int t = 0; t < nt; t += 2) {
            const bool last = (t == nt - 2);
            const char* a1 = cA + (size_t)(t + 1) * kstep;
            const char* a2 = last ? nA : cA + (size_t)(t + 2) * kstep; const char* b2 = last ? nB : cB + (size_t)(t + 2) * kstep;
            const char* a3 = a2 + kstep; const char* b3 = b2 + kstep;
            if (last && has_next) S.a_ready(nxt);
            if constexpr (SP2) {
            PG8_LDB(B0, 0, 0); PG8_LDB(B1, 0, 1); PG8_SCHED; PG8_LDA(At, 0, 0); PG8_STAGE(PG8_SA(1, 1), a1 + hstepA, voffA);
            PG8_WAIT_V(8); PG8_WAIT_L(0); PG8_BAR; PG8_MMA(0, 0, At, B0); PG8_MMA(0, 1, At, B1); PG8_BAR; PG8_SCHED;
            PG8_LDA(At, 0, 1); PG8_STAGE(PG8_SB(0, 0), b2, voffB); PG8_STAGE(PG8_SB(0, 1), b2 + hstepB, voffB); PG8_STAGE(PG8_SA(0, 0), a2, voffA);
            PG8_WAIT_V(8); PG8_WAIT_L(0); PG8_BAR; PG8_MMA(1, 0, At, B0); PG8_MMA(1, 1, At, B1); PG8_BAR; PG8_SCHED;
            PG8_LDB(B0, 1, 0); PG8_LDB(B1, 1, 1); PG8_SCHED; PG8_LDA(At, 1, 0); PG8_STAGE(PG8_SA(0, 1), a2 + hstepA, voffA);
            PG8_WAIT_V(8); PG8_WAIT_L(0); PG8_BAR; PG8_MMA(0, 0, At, B0); PG8_MMA(0, 1, At, B1); PG8_BAR; PG8_SCHED;
            PG8_LDA(At, 1, 1); PG8_STAGE(PG8_SB(1, 0), b3, voffB); PG8_STAGE(PG8_SB(1, 1), b3 + hstepB, voffB); PG8_STAGE(PG8_SA(1, 0), a3, voffA);
            PG8_WAIT_V(8); PG8_WAIT_L(0); PG8_BAR; PG8_MMA(1, 0, At, B0); PG8_MMA(1, 1, At, B1); PG8_BAR; PG8_SCHED;
            } else {
            PG8_LDB(B0, 0, 0); PG8_SCHED; PG8_LDA(At, 0, 0); PG8_STAGE(PG8_SA(1, 1), a1 + hstepA, voffA);
            PG8_WAIT_L(8); PG8_BAR; PG8_WAIT_L(0); PG8_MMA(0, 0, At, B0); PG8_BAR; PG8_SCHED;
            PG8_LDB(B1, 0, 1); PG8_STAGE(PG8_SB(0, 0), b2, voffB);
            PG8_BAR; PG8_WAIT_L(0); PG8_MMA(0, 1, At, B1); PG8_BAR;
            PG8_LDA(At, 0, 1); PG8_STAGE(PG8_SA(0, 0), a2, voffA);
            PG8_BAR; PG8_WAIT_L(0); PG8_MMA(1, 0, At, B0); PG8_BAR; PG8_SCHED;
            PG8_STAGE(PG8_SB(0, 1), b2 + hstepB, voffB);
            PG8_WAIT_V(6); PG8_BAR; PG8_MMA(1, 1, At, B1); PG8_BAR;
            PG8_LDB(B0, 1, 0); PG8_SCHED; PG8_LDA(At, 1, 0); PG8_STAGE(PG8_SA(0, 1), a2 + hstepA, voffA);
            PG8_WAIT_L(8); PG8_BAR; PG8_WAIT_L(0); PG8_MMA(0, 0, At, B0); PG8_BAR; PG8_SCHED;
            PG8_LDB(B1, 1, 1); PG8_STAGE(PG8_SB(1, 0), b3, voffB);
            PG8_BAR; PG8_WAIT_L(0); PG8_MMA(0, 1, At, B1); PG8_BAR;
            PG8_LDA(At, 1, 1); PG8_STAGE(PG8_SA(1, 0), a3, voffA);
            PG8_BAR; PG8_WAIT_L(0); PG8_MMA(1, 0, At, B0); PG8_BAR; PG8_SCHED;
            PG8_STAGE(PG8_SB(1, 1), b3 + hstepB, voffB);
            PG8_WAIT_V(6); PG8_BAR; PG8_MMA(1, 1, At, B1); PG8_BAR;
            }
        }
        if constexpr (ALIGN_EPI) { if (wr == 0) PG8_BAR; }
        if constexpr (!Epi::AFTER_DRAIN) { E(acc, cur, wr, wc, fr, fq); S.done(cur); }
        if (!has_next) break;
#pragma unroll
        for (int a = 0; a < 2; ++a)
#pragma unroll
            for (int b = 0; b < 2; ++b)
#pragma unroll
                for (int m = 0; m < 4; ++m)
#pragma unroll
                    for (int n = 0; n < 2; ++n) acc[a][b][m][n] = (f32x4){0.f, 0.f, 0.f, 0.f};
        cur = nxt; cA = nA; cB = nB; ++ui;
        if constexpr (ALIGN_EPI) { if (wr == 1) PG8_BAR; }
    }
    PG8_WAIT_V(0);
    if constexpr (!ALIGN_EPI) { if (wr == 0) PG8_BAR; }
    PG8_BAR;
    if constexpr (Epi::AFTER_DRAIN) { E.fused(acc, cur, wr, wc, fr, fq, lds, wid, lane); S.done(cur); }
#undef PG8_SA
#undef PG8_SB
#undef PG8_STAGE
#undef PG8_LDA
#undef PG8_LDB
#undef PG8_MMA
#undef PG8_WAIT_V
#undef PG8_WAIT_L
#undef PG8_BAR
#undef PG8_SCHED
}
}
#define GAS __attribute__((address_space(1)))
#define LAS __attribute__((address_space(3)))
typedef unsigned short bf16;
typedef unsigned v4u __attribute__((ext_vector_type(4)));
typedef float f32x4 __attribute__((ext_vector_type(4)));
typedef short bf16x8 __attribute__((ext_vector_type(8)));
typedef GAS unsigned gu32;
typedef GAS unsigned long long gu64;
#define RLX_AGENT __ATOMIC_RELAXED, __HIP_MEMORY_SCOPE_AGENT
#define LDS_WAIT() asm volatile("s_waitcnt lgkmcnt(0)" ::: "memory")
#define VM_WAIT() asm volatile("s_waitcnt vmcnt(0)" ::: "memory")
__device__ __forceinline__ unsigned long long rt() { return __builtin_amdgcn_s_memrealtime(); }
__device__ __forceinline__ unsigned f2bf(float f) { unsigned u = __builtin_bit_cast(unsigned, f); return (u + 0x7fffu + ((u >> 16) & 1u)) >> 16; }
__device__ __forceinline__ unsigned pk2(float lo, float hi) { return f2bf(lo) | (f2bf(hi) << 16); }

#define XB_TMO      128
#define XB_XCNT(j)  (256  + 64 * (j))
#define XB_XSUB(j)  (1280 + 64 * (j))
#define XB_XGEN(j)  (2304 + 64 * (j))
#define XB_TOP      3328
#define XB_TOPGEN   3392
#define XCD_BAR_WORDS 3456
#define XB_SPIN_CAP (1u << 18)

__device__ __forceinline__ unsigned xb_ld(unsigned* p)              { return __hip_atomic_load(p, __ATOMIC_RELAXED, __HIP_MEMORY_SCOPE_AGENT); }
__device__ __forceinline__ unsigned xb_add(unsigned* p, unsigned v) { return __hip_atomic_fetch_add(p, v, __ATOMIC_RELAXED, __HIP_MEMORY_SCOPE_AGENT); }
__device__ __forceinline__ unsigned xb_xcc_id() { return (unsigned)__builtin_amdgcn_s_getreg((3 << 11) | 20) & 0xFu; }
#define XB_SPIN(cond, bar) do { unsigned _sp = 0; while (cond) { __builtin_amdgcn_s_sleep(1); \
    if ((++_sp & 255u) == 0u) { if (xb_ld(&(bar)[XB_TMO])) break; if (_sp > XB_SPIN_CAP) { atomicAdd(&(bar)[XB_TMO], 1u); break; } } } } while (0)

struct XcdBarrier {
    unsigned* bar; unsigned x;
    volatile LAS unsigned* st;
};

__device__ __forceinline__ XcdBarrier xcd_barrier_post(unsigned* bar, volatile LAS unsigned* st) {
    XcdBarrier b; b.bar = bar; b.x = xb_xcc_id(); b.st = st;
    if (threadIdx.x == 0) (void)xb_add(&bar[XB_XCNT(b.x)], 1u);
    return b;
}
__device__ __forceinline__ void xcd_barrier_complete(unsigned* bar, unsigned x, unsigned& nloc, unsigned& nx) {
    const unsigned G = gridDim.x * gridDim.y * gridDim.z;
    unsigned sum, cnt, mine, sp = 0u;
    for (;;) {
        sum = 0u; cnt = 0u; mine = 0u;
#pragma unroll
        for (unsigned j = 0; j < 16; ++j) { const unsigned c = xb_ld(&bar[XB_XCNT(j)]); sum += c; cnt += (c > 0u) ? 1u : 0u; mine = (j == x) ? c : mine; }
        if (sum == G) break;
        __builtin_amdgcn_s_sleep(1);
        if ((++sp & 255u) == 0u) { if (xb_ld(&bar[XB_TMO])) break; if (sp > XB_SPIN_CAP) { atomicAdd(&bar[XB_TMO], 1u); break; } }
    }
    nloc = mine > 0u ? mine : 1u; nx = cnt > 0u ? cnt : 1u;
}

__device__ __forceinline__ void xcd_barrier(const XcdBarrier& b) {
    asm volatile("s_waitcnt vmcnt(0)" ::: "memory");
    __syncthreads();
    if (threadIdx.x == 0) {
        unsigned* bar = b.bar;
        __builtin_amdgcn_s_waitcnt(0);
        unsigned nloc = b.st[0], nx = b.st[1];
        if (nloc == 0u) { xcd_barrier_complete(bar, b.x, nloc, nx); b.st[0] = nloc; b.st[1] = nx; }
        const unsigned old = xb_add(&bar[XB_XSUB(b.x)], 1u);
        const unsigned gen = old / nloc;
        if (old + 1u == (gen + 1u) * nloc) {
            __builtin_amdgcn_fence(__ATOMIC_RELEASE, "agent");
            asm volatile("s_waitcnt vmcnt(0)" ::: "memory");
            const unsigned og = xb_add(&bar[XB_TOP], 1u);
            const unsigned tg = og / nx;
            if (og + 1u == (tg + 1u) * nx) xb_add(&bar[XB_TOPGEN], 1u);
            else XB_SPIN(xb_ld(&bar[XB_TOPGEN]) == tg, bar);
            __builtin_amdgcn_fence(__ATOMIC_ACQUIRE, "agent");
            xb_add(&bar[XB_XGEN(b.x)], 1u);
            asm volatile("s_waitcnt vmcnt(0)" ::: "memory");
        } else {
            XB_SPIN(xb_ld(&bar[XB_XGEN(b.x)]) == gen, bar);
            __builtin_amdgcn_fence(__ATOMIC_ACQUIRE, "agent");
            asm volatile("s_waitcnt vmcnt(0)" ::: "memory");
        }
    }
    __syncthreads();
}

#ifndef PHMASK
#define PHMASK 0xffff
#endif
#ifndef ONE_LAUNCH
#define ONE_LAUNCH 1
#endif
constexpr int NWAVES = 8, NTHR = 512;
constexpr int NB = 2, T = 8192, LC = 256, D = 1024, RL = NB * T, RC = NB * LC, R = RL + RC, DEPTH = 4;
constexpr int HYB_IN = 2560, RET_IN = 6144, FF = 2816, FF2 = 5632;
constexpr float EPS = 1e-6f;
constexpr size_t MiB = 1u << 20;
constexpr size_t WS_CTL = 0, CTL_ZERO_BYTES = 1 * MiB;
constexpr size_t WS_MODS = 1 * MiB;
constexpr size_t WS_ROPE = 1 * MiB + 512 * 1024;
constexpr size_t WS_XCTX = 2 * MiB;
constexpr size_t WS_W = 8 * MiB;
constexpr size_t WS_H = 42 * MiB;
constexpr size_t WS_BIG2 = 75 * MiB;
constexpr size_t WS_BIG1 = 174 * MiB;
constexpr size_t WS_ST = WS_H;
constexpr size_t WS_END = 372 * MiB;
constexpr size_t WO_IN = 0, WO_OUT = 6291456, WO_FIN = 8388608, WO_FOUT = 14155776;
constexpr int CW_BAR = 4096;
constexpr int RING_BYTES = 131072, LDS_BYTES = 147456, LDSCTL_OFF = LDS_BYTES - 512, MISC_OFF = LDSCTL_OFF + 320;
constexpr int NPHASE = 41;

struct Params { const float* in[20]; float* out; unsigned char* ws; int ph_lo, ph_hi; };
__device__ __forceinline__ const Params& params() { const void* p = (const void*)__builtin_amdgcn_kernarg_segment_ptr(); asm volatile("" : "+s"(p)); return *(const Params*)p; }

__device__ __forceinline__ float bf2f(unsigned short b) { return __uint_as_float(((unsigned)b) << 16); }
__device__ __forceinline__ float bflo(unsigned u) { return __uint_as_float(u << 16); }
__device__ __forceinline__ float bfhi(unsigned u) { return __uint_as_float(u & 0xffff0000u); }
__device__ __forceinline__ float wave_sum(float v) {
#pragma unroll
    for (int o = 1; o < 64; o <<= 1) v += __shfl_xor(v, o);
    return v;
}
__device__ __forceinline__ float wave_max(float v) {
#pragma unroll
    for (int o = 1; o < 64; o <<= 1) v = fmaxf(v, __shfl_xor(v, o));
    return v;
}
__device__ __forceinline__ float silu_f(float x) { return x / (1.f + __expf(-x)); }
__device__ __forceinline__ float gelu_f(float x) { const float u = 0.7978845608028654f * (x + 0.044715f * x * x * x); return 0.5f * x * (1.f + tanhf(u)); }
__device__ __forceinline__ float* xrow(const Params& P, int r) { return r < RL ? P.out + (size_t)r * D : (float*)(P.ws + WS_XCTX) + (size_t)(r - RL) * D; }
__device__ __forceinline__ int modset(int r) { return r < RL ? (r >= T ? 1 : 0) : 2; }
__device__ __forceinline__ const float* modp(const Params& P, int layer, int set, int j) { return (const float*)(P.ws + WS_MODS) + ((size_t)((layer * 3 + set) * 6 + j)) * D; }

__device__ __forceinline__ void ph_init(const Params& P, unsigned char* lds) {
    const int tid = tid_fresh(), G = grid_fresh(), bid = bid_fresh();
    {
        const float4* xs = (const float4*)P.in[0]; float4* xd = (float4*)P.out;
        const size_t n4 = (size_t)RL * D / 4;
        for (size_t i = (size_t)bid * NTHR + tid; i < n4; i += (size_t)G * NTHR) xd[i] = xs[i];
        const float4* cs = (const float4*)P.in[2]; float4* cd = (float4*)(P.ws + WS_XCTX);
        const size_t m4 = (size_t)RC * D / 4;
        for (size_t i = (size_t)bid * NTHR + tid; i < m4; i += (size_t)G * NTHR) cd[i] = cs[i];
    }
    float* sv = (float*)lds;
    float* red = sv + 3072;
    float* mods = (float*)(P.ws + WS_MODS);
    for (int u = bid; u < DEPTH * 48; u += G) {
        const int l = u / 48, cb = u % 48;
        for (int i = tid; i < 3072; i += NTHR) { const int set = i >> 10, k = i & 1023; const float c = set < 2 ? P.in[1][set * D + k] : P.in[3][k]; sv[i] = c / (1.f + expf(-c)); }
        __syncthreads();
        const int kg = tid >> 7, nn = tid & 127, n = cb * 128 + nn;
        const float* w = P.in[4] + (size_t)l * D * 6144 + n;
        float a0 = 0.f, a1 = 0.f, a2 = 0.f;
#pragma unroll 8
        for (int k = kg * 256; k < kg * 256 + 256; ++k) { const float wv = w[(size_t)k * 6144]; a0 += sv[k] * wv; a1 += sv[1024 + k] * wv; a2 += sv[2048 + k] * wv; }
        red[(kg * 3 + 0) * 128 + nn] = a0; red[(kg * 3 + 1) * 128 + nn] = a1; red[(kg * 3 + 2) * 128 + nn] = a2;
        __syncthreads();
        if (tid < 384) { const int set = tid >> 7; float s = P.in[5][l * 6144 + n];
            s += red[(0 * 3 + set) * 128 + nn] + red[(1 * 3 + set) * 128 + nn] + red[(2 * 3 + set) * 128 + nn] + red[(3 * 3 + set) * 128 + nn];
            mods[(size_t)(l * 3 + set) * 6144 + n] = s; }
        __syncthreads();
    }
    float* tab = (float*)(P.ws + WS_ROPE);
    for (int i = bid * NTHR + tid; i < 192 * 32; i += G * NTHR) {
        const int p = i >> 5, f = i & 31; const float inv = powf(10000.f, -(float)f / 32.f); const float pos = (float)(p < 128 ? p : p - 128); const float ang = pos * inv;
        tab[2 * i] = cosf(ang); tab[2 * i + 1] = sinf(ang);
    }
}

__device__ __forceinline__ void transpose_item(const float* W, int K, int N, bf16* WT, LAS float* scr, int item, int lane, bool ropeperm = false) {
    const int nblk = N / 32, kb = item / nblk, nb = item % nblk, k0 = 64 * kb, n0 = 32 * nb;
    int nd = n0; if (ropeperm && n0 < 2048) { const int c = n0 & 255; nd = (n0 & ~255) + 128 * ((c >> 6) & 1) + 64 * (c >> 7) + (c & 63); }
#pragma unroll 8
    for (int i = 0; i < 32; ++i) { const int kk = 2 * i + (lane >> 5); scr[kk * 33 + (lane & 31)] = W[(size_t)(k0 + kk) * N + n0 + (lane & 31)]; }
    LDS_WAIT(); asm volatile("" ::: "memory");
    const int c = lane & 7;
#pragma unroll
    for (int j = 0; j < 4; ++j) { const int n = (lane >> 3) + 8 * j; const LAS float* s = scr + (8 * c) * 33 + n;
        v4u o; o.x = pk2(s[0 * 33], s[1 * 33]); o.y = pk2(s[2 * 33], s[3 * 33]); o.z = pk2(s[4 * 33], s[5 * 33]); o.w = pk2(s[6 * 33], s[7 * 33]);
        *(GAS v4u*)(WT + (size_t)(nd + n) * K + k0 + 8 * c) = o; }
    LDS_WAIT(); asm volatile("" ::: "memory");
}
__device__ __forceinline__ void ph_wconv(const Params& P, int layer, LAS unsigned char* lds) {
    const int tid = tid_fresh(), lane = tid & 63, wave = __builtin_amdgcn_readfirstlane(tid >> 6);
    LAS float* scr = (LAS float*)(lds + wave * 16384);
    const int gw = bid_fresh() * NWAVES + wave, NGW = grid_fresh() * NWAVES;
    const int j = layer >> 1; const bool even = (layer & 1) == 0;
    bf16* WB = (bf16*)(P.ws + WS_W);
    const float* w_in = even ? P.in[7] + (size_t)j * D * HYB_IN : P.in[12] + (size_t)j * D * RET_IN;
    const int n_in = even ? HYB_IN : RET_IN;
    const float* w_out = even ? P.in[11] + (size_t)j * D * D : P.in[15] + (size_t)j * 2048 * D;
    const int k_out = even ? D : 2048;
    const float* wf_in = P.in[16] + (size_t)layer * D * FF2;
    const float* wf_out = P.in[19] + (size_t)layer * FF * D;
    const int I0 = (D / 64) * (n_in / 32), I1 = (k_out / 64) * (D / 32), I2 = (D / 64) * (FF2 / 32), I3 = (FF / 64) * (D / 32);
    const int NIT = I0 + I1 + I2 + I3;
    for (int it = gw; it < NIT; it += NGW) {
        int r = it;
        if (r < I0) { transpose_item(w_in, D, n_in, WB + WO_IN, scr, r, lane, !even); continue; } r -= I0;
        if (r < I1) { transpose_item(w_out, k_out, D, WB + WO_OUT, scr, r, lane); continue; } r -= I1;
        if (r < I2) { transpose_item(wf_in, D, FF2, WB + WO_FIN, scr, r, lane); continue; } r -= I2;
        transpose_item(wf_out, FF, D, WB + WO_FOUT, scr, r, lane);
    }
}

__device__ __forceinline__ void ph_normmod(const Params& P, int layer) {
    const int tid = tid_fresh(), lane = tid & 63, wave = tid >> 6;
    const int gw = bid_fresh() * NWAVES + wave, NGW = grid_fresh() * NWAVES;
    bf16* H = (bf16*)(P.ws + WS_H);
    const float* ng = P.in[6] + (size_t)(layer * 4 + 0) * D;
    for (int r = gw; r < R; r += NGW) {
        const float4* xr = (const float4*)xrow(P, r) + lane;
        float4 v[4]; float ss = 0.f;
#pragma unroll
        for (int j = 0; j < 4; ++j) { v[j] = xr[64 * j]; ss += (v[j].x * v[j].x + v[j].y * v[j].y) + (v[j].z * v[j].z + v[j].w * v[j].w); }
        const float rs = 1.f / sqrtf(wave_sum(ss) * (1.f / D) + EPS);
        const int set = modset(r); const float* sh = modp(P, layer, set, 0); const float* sc = modp(P, layer, set, 1);
#pragma unroll
        for (int j = 0; j < 4; ++j) { const int col = 4 * lane + 256 * j;
            const float4 g4 = *(const float4*)(ng + col), sh4 = *(const float4*)(sh + col), sc4 = *(const float4*)(sc + col);
            const float o0 = v[j].x * rs * g4.x * (1.f + sc4.x) + sh4.x, o1 = v[j].y * rs * g4.y * (1.f + sc4.y) + sh4.y;
            const float o2 = v[j].z * rs * g4.z * (1.f + sc4.z) + sh4.z, o3 = v[j].w * rs * g4.w * (1.f + sc4.w) + sh4.w;
            uint2 w; w.x = pk2(o0, o1); w.y = pk2(o2, o3); *(uint2*)(H + (size_t)r * D + col) = w; }
    }
}
__device__ __forceinline__ void ph_resid(const Params& P, int layer, int stage, const float* Y) {
    const int tid = tid_fresh(), lane = tid & 63, wave = tid >> 6;
    const int gw = bid_fresh() * NWAVES + wave, NGW = grid_fresh() * NWAVES;
    bf16* H = (bf16*)(P.ws + WS_H);
    const float* ngA = P.in[6] + (size_t)(layer * 4 + (stage == 1 ? 1 : 3)) * D;
    const float* ngB = P.in[6] + (size_t)(layer * 4 + 2) * D;
    const int rmax = (layer == DEPTH - 1) ? RL : R;
    for (int r = gw; r < rmax; r += NGW) {
        const float4* yr = (const float4*)(Y + (size_t)r * D) + lane; float4* xr = (float4*)xrow(P, r) + lane;
        float4 y[4]; float ss = 0.f;
#pragma unroll
        for (int j = 0; j < 4; ++j) { y[j] = yr[64 * j]; ss += (y[j].x * y[j].x + y[j].y * y[j].y) + (y[j].z * y[j].z + y[j].w * y[j].w); }
        const float rsy = 1.f / sqrtf(wave_sum(ss) * (1.f / D) + EPS);
        const int set = modset(r); const float* gate = modp(P, layer, set, stage == 1 ? 2 : 5);
        float4 x[4]; float sx = 0.f;
#pragma unroll
        for (int j = 0; j < 4; ++j) { const int col = 4 * lane + 256 * j; const float4 g4 = *(const float4*)(ngA + col), gt = *(const float4*)(gate + col); float4 xv = xr[64 * j];
            xv.x += gt.x * (y[j].x * rsy * g4.x); xv.y += gt.y * (y[j].y * rsy * g4.y); xv.z += gt.z * (y[j].z * rsy * g4.z); xv.w += gt.w * (y[j].w * rsy * g4.w);
            x[j] = xv; xr[64 * j] = xv; sx += (xv.x * xv.x + xv.y * xv.y) + (xv.z * xv.z + xv.w * xv.w); }
        if (stage == 1) {
            const float rs = 1.f / sqrtf(wave_sum(sx) * (1.f / D) + EPS);
            const float* sh = modp(P, layer, set, 3); const float* sc = modp(P, layer, set, 4);
#pragma unroll
            for (int j = 0; j < 4; ++j) { const int col = 4 * lane + 256 * j;
                const float4 g4 = *(const float4*)(ngB + col), sh4 = *(const float4*)(sh + col), sc4 = *(const float4*)(sc + col);
                const float o0 = x[j].x * rs * g4.x * (1.f + sc4.x) + sh4.x, o1 = x[j].y * rs * g4.y * (1.f + sc4.y) + sh4.y;
                const float o2 = x[j].z * rs * g4.z * (1.f + sc4.z) + sh4.z, o3 = x[j].w * rs * g4.w * (1.f + sc4.w) + sh4.w;
                uint2 w; w.x = pk2(o0, o1); w.y = pk2(o2, o3); *(uint2*)(H + (size_t)r * D + col) = w; }
        }
    }
}

typedef short v4i16_t __attribute__((ext_vector_type(4)));
__device__ __forceinline__ v4i16_t ds_tr16(LAS const unsigned char* p) { return __builtin_amdgcn_ds_read_tr16_b64_v4i16((LAS v4i16_t*)p); }
__device__ __forceinline__ bf16x8 cat8(v4i16_t lo, v4i16_t hi) { return (bf16x8){lo[0], lo[1], lo[2], lo[3], hi[0], hi[1], hi[2], hi[3]}; }
__device__ __forceinline__ f32x4 mfma16(bf16x8 a, bf16x8 b, f32x4 c) { return __builtin_amdgcn_mfma_f32_16x16x32_bf16(a, b, c, 0, 0, 0); }
__device__ __forceinline__ size_t st_slot(int dir, int b, int h, int idx) { return ((size_t)(((dir * 2 + b) * 8 + h) * 66 + idx)) * 32768; }
constexpr float LOG2E = 1.4426950408889634f;

__device__ __forceinline__ void ph_attn(const Params& P, int layer, LAS unsigned char* lds) {
    const int tid = tid_fresh(), lane = tid & 63, w = __builtin_amdgcn_readfirstlane(tid >> 6), l15 = lane & 15, g = lane >> 4, q4 = (lane & 15) >> 2, p4 = lane & 3;
    const bf16* QKV = (const bf16*)(P.ws + WS_BIG1); bf16* O = (bf16*)(P.ws + WS_BIG2);
    const float* rpbg = P.in[8] + (size_t)(layer >> 1) * 8 * 465;
    constexpr int KS = 0, VS = 18432, RP = 36864;
    LAS float* rp = (LAS float*)(lds + RP);
    const float SC = 0.125f * LOG2E, NEG = -1.0e30f;
    for (int u = bid_fresh(); u < 1056; u += grid_fresh()) {
        const bool isctx = u >= 1024; int b, h, m;
        if (!isctx) { b = u >> 9; h = (u >> 6) & 7; m = u & 63; } else { const int v = u - 1024; b = v >> 4; h = (v >> 1) & 7; m = v & 1; }
        const int qr = 2 * m + (w >> 2), qc = 16 * (w & 3) + l15;
        const int qrow = isctx ? RL + b * LC + 128 * m + 16 * w + l15 : b * T + qr * 64 + qc;
        const int r0q = min(max(qr - 4, 0), 120), c0q = min(max(qc - 8, 0), 48);
        const int kb = min(max(2 * m - 4, 0), 120);
        __syncthreads();
        if (tid < 465) rp[tid] = rpbg[h * 465 + tid] * LOG2E;
        bf16x8 qf[2];
#pragma unroll
        for (int ks = 0; ks < 2; ++ks) qf[ks] = *(const bf16x8*)(QKV + (size_t)qrow * HYB_IN + h * 64 + 32 * ks + 8 * g);
        float zf = 0.f; asm volatile("" : "+v"(zf)); const f32x4 zero4 = (f32x4){zf, zf, zf, zf};
        float mrun = NEG, lrun = zf; f32x4 oacc[4];
#pragma unroll
        for (int dt = 0; dt < 4; ++dt) oacc[dt] = zero4;
        const int nsteps = isctx ? 2 : 7;
        for (int st = 0; st < nsteps; ++st) {
            const bool cstep = isctx || st >= 5; const int cs = isctx ? st : st - 5;
            __syncthreads();
            {
                const int r = tid >> 2, qd = tid & 3; int krow;
                if (cstep) krow = RL + b * LC + 128 * cs + r; else { const int kr = min(kb + 2 * st + (r >> 6), 127); krow = b * T + kr * 64 + (r & 63); }
                const v4u* kp = (const v4u*)(QKV + (size_t)krow * HYB_IN + 512 + h * 64 + qd * 16); const v4u* vp = (const v4u*)(QKV + (size_t)krow * HYB_IN + 1024 + h * 64 + qd * 16);
                const v4u k0 = kp[0], k1 = kp[1], v0 = vp[0], v1 = vp[1];
                *(LAS v4u*)(lds + KS + r * 144 + qd * 32) = k0; *(LAS v4u*)(lds + KS + r * 144 + qd * 32 + 16) = k1;
                *(LAS v4u*)(lds + VS + r * 144 + qd * 32) = v0; *(LAS v4u*)(lds + VS + r * 144 + qd * 32 + 16) = v1;
            }
            __syncthreads();
#pragma unroll
            for (int half = 0; half < 2; ++half) {
                const int krh = kb + 2 * st + half;
                const bool need = cstep || (krh >= r0q && krh <= r0q + 7);
                if (need) {
                    f32x4 sacc[4];
#pragma unroll
                    for (int kt = 0; kt < 4; ++kt) { sacc[kt] = zero4;
#pragma unroll
                        for (int ks = 0; ks < 2; ++ks) { const bf16x8 kf = *(LAS const bf16x8*)(lds + KS + (64 * half + 16 * kt + l15) * 144 + (32 * ks + 8 * g) * 2); sacc[kt] = mfma16(kf, qf[ks], sacc[kt]); } }
                    float sv[16]; float mx = NEG;
#pragma unroll
                    for (int kt = 0; kt < 4; ++kt)
#pragma unroll
                        for (int rg = 0; rg < 4; ++rg) { float t = sacc[kt][rg] * SC;
                            if (!cstep) { const int kc = 16 * kt + 4 * g + rg; const bool valid = kc >= c0q && kc < c0q + 16; const int dcc = min(max(kc - qc, -15), 15) + 15;
                                const int bi = min(max((krh - qr + 7) * 31 + dcc, 0), 464); t = valid ? t + rp[bi] : NEG; }
                            sv[kt * 4 + rg] = t; mx = fmaxf(mx, t); }
                    mx = fmaxf(mx, __shfl_xor(mx, 16)); mx = fmaxf(mx, __shfl_xor(mx, 32));
                    const float mnew = fmaxf(mrun, mx), alpha = __builtin_amdgcn_exp2f(mrun - mnew); mrun = mnew;
                    float ps = 0.f;
#pragma unroll
                    for (int e = 0; e < 16; ++e) { sv[e] = __builtin_amdgcn_exp2f(sv[e] - mnew); ps += sv[e]; }
                    lrun = lrun * alpha + ps;
#pragma unroll
                    for (int dt = 0; dt < 4; ++dt) oacc[dt] = oacc[dt] * alpha;
#pragma unroll
                    for (int sx = 0; sx < 2; ++sx) {
                        v4u pu; pu.x = pk2(sv[8 * sx + 0], sv[8 * sx + 1]); pu.y = pk2(sv[8 * sx + 2], sv[8 * sx + 3]); pu.z = pk2(sv[8 * sx + 4], sv[8 * sx + 5]); pu.w = pk2(sv[8 * sx + 6], sv[8 * sx + 7]);
                        const bf16x8 pfr = __builtin_bit_cast(bf16x8, pu);
#pragma unroll
                        for (int dt = 0; dt < 4; ++dt) {
                            LAS const unsigned char* pv = lds + VS + (64 * half + 32 * sx + 4 * g + q4) * 144 + (16 * dt + 4 * p4) * 2;
                            const bf16x8 vfr = cat8(ds_tr16(pv), ds_tr16(pv + 16 * 144));
                            oacc[dt] = mfma16(vfr, pfr, oacc[dt]);
                        }
                    }
                }
            }
        }
        lrun += __shfl_xor(lrun, 16); lrun += __shfl_xor(lrun, 32);
        const float inv = 1.f / lrun;
#pragma unroll
        for (int dt = 0; dt < 4; ++dt) { uint2 ow; ow.x = pk2(oacc[dt][0] * inv, oacc[dt][1] * inv); ow.y = pk2(oacc[dt][2] * inv, oacc[dt][3] * inv);
            *(uint2*)(O + (size_t)qrow * D + h * 64 + 16 * dt + 4 * g) = ow; }
    }
}

__device__ __forceinline__ void ph_sgu(const Params& P, int layer, LAS unsigned char* lds) {
    const int tid = tid_fresh(), lane = tid & 63, w = __builtin_amdgcn_readfirstlane(tid >> 6), l15 = lane & 15, g = lane >> 4, q4 = (lane & 15) >> 2, p4 = lane & 3;
    const bf16* QKV = (const bf16*)(P.ws + WS_BIG1); bf16* O = (bf16*)(P.ws + WS_BIG2);
    const int j = layer >> 1;
    constexpr int VN = 0, VP = 1040;
    const int G = grid_fresh();
    for (int uu = G - 1 - bid_fresh(); uu < R / 128; uu += G) {
        const int row0 = uu * 128;
        __syncthreads();
        {
            const int r = tid >> 2, qd = tid & 3;
            const v4u* gp = (const v4u*)(QKV + (size_t)(row0 + r) * HYB_IN + 2048 + qd * 128);
            v4u x[16]; float sm = 0.f, s2 = 0.f;
#pragma unroll
            for (int i = 0; i < 16; ++i) { x[i] = gp[i];
                const float a0 = bflo(x[i].x), a1 = bfhi(x[i].x), a2 = bflo(x[i].y), a3 = bfhi(x[i].y), a4 = bflo(x[i].z), a5 = bfhi(x[i].z), a6 = bflo(x[i].w), a7 = bfhi(x[i].w);
                sm += ((a0 + a1) + (a2 + a3)) + ((a4 + a5) + (a6 + a7)); s2 += ((a0 * a0 + a1 * a1) + (a2 * a2 + a3 * a3)) + ((a4 * a4 + a5 * a5) + (a6 * a6 + a7 * a7)); }
            sm += __shfl_xor(sm, 1); sm += __shfl_xor(sm, 2); s2 += __shfl_xor(s2, 1); s2 += __shfl_xor(s2, 2);
            const float mu = sm * (1.f / 512.f); const float var = fmaxf(s2 * (1.f / 512.f) - mu * mu, 0.f); const float rsd = 1.f / sqrtf(var + EPS);
#pragma unroll
            for (int i = 0; i < 16; ++i) { v4u o;
                o.x = pk2((bflo(x[i].x) - mu) * rsd, (bfhi(x[i].x) - mu) * rsd); o.y = pk2((bflo(x[i].y) - mu) * rsd, (bfhi(x[i].y) - mu) * rsd);
                o.z = pk2((bflo(x[i].z) - mu) * rsd, (bfhi(x[i].z) - mu) * rsd); o.w = pk2((bflo(x[i].w) - mu) * rsd, (bfhi(x[i].w) - mu) * rsd);
                *(LAS v4u*)(lds + VN + r * VP + qd * 256 + i * 16) = o; }
        }
        __syncthreads();
        float zf = 0.f; asm volatile("" : "+v"(zf)); const f32x4 zero4 = (f32x4){zf, zf, zf, zf};
        for (int gg = 0; gg < 8; ++gg) {
            const float* wsp = P.in[9] + ((size_t)(j * 8 + gg) * 128 + 16 * w + l15) * 128 + 8 * g;
            bf16x8 af[4];
#pragma unroll
            for (int ks = 0; ks < 4; ++ks) { const float4 w0 = *(const float4*)(wsp + 32 * ks), w1 = *(const float4*)(wsp + 32 * ks + 4);
                v4u t; t.x = pk2(w0.x, w0.y); t.y = pk2(w0.z, w0.w); t.z = pk2(w1.x, w1.y); t.w = pk2(w1.z, w1.w); af[ks] = __builtin_bit_cast(bf16x8, t); }
            f32x4 acc[4];
#pragma unroll
            for (int ct = 0; ct < 4; ++ct) acc[ct] = zero4;
#pragma unroll
            for (int ks = 0; ks < 4; ++ks)
#pragma unroll
                for (int ct = 0; ct < 4; ++ct) {
                    LAS const unsigned char* pv = lds + VN + (32 * ks + 8 * g + q4) * VP + (gg * 64 + 16 * ct + 4 * p4) * 2;
                    const bf16x8 bv = cat8(ds_tr16(pv), ds_tr16(pv + 4 * VP));
                    acc[ct] = mfma16(af[ks], bv, acc[ct]);
                }
            const float* bsp = P.in[10] + (size_t)(j * 8 + gg) * 128 + 16 * w + 4 * g;
#pragma unroll
            for (int rg = 0; rg < 4; ++rg) { const int row = row0 + 16 * w + 4 * g + rg; const float bb = bsp[rg];
#pragma unroll
                for (int ct = 0; ct < 4; ++ct) { const int c = gg * 64 + 16 * ct + l15; const float uv = bf2f(QKV[(size_t)row * HYB_IN + 1536 + c]);
                    O[(size_t)row * D + 512 + c] = (bf16)f2bf(uv * (acc[ct][rg] + bb)); } }
        }
    }
}

__device__ __forceinline__ void ph_ret_kv(const Params& P, int layer, LAS unsigned char* lds) {
    const int tid = tid_fresh(), lane = tid & 63, w = __builtin_amdgcn_readfirstlane(tid >> 6), l15 = lane & 15, g = lane >> 4, q4 = (lane & 15) >> 2, p4 = lane & 3;
    const bf16* QKVG = (const bf16*)(P.ws + WS_BIG1); bf16* ST = (bf16*)(P.ws + WS_ST);
    const int j = layer >> 1;
    constexpr int KF = 0, KB = 34816, VS = 69632;
    for (int u = bid_fresh(); u < 16 * 66; u += grid_fresh()) {
        const int idx = u % 66, bh = u / 66, b = bh >> 3, h = bh & 7;
        const int row0 = idx < 2 ? RL + b * LC + 128 * idx : b * T + 128 * (idx - 2);
        const float l2f = P.in[13][(j * 2 + 0) * 8 + h] * LOG2E, l2b = P.in[13][(j * 2 + 1) * 8 + h] * LOG2E;
        __syncthreads();
        {
            const int r = tid >> 2, qd = tid & 3;
            const v4u* kp = (const v4u*)(QKVG + (size_t)(row0 + r) * RET_IN + 1024 + h * 128 + qd * 32);
            const float wf = __builtin_amdgcn_exp2f(l2f * (float)(127 - r)), wb = __builtin_amdgcn_exp2f(l2b * (float)r);
#pragma unroll
            for (int i = 0; i < 4; ++i) { const v4u kv = kp[i]; v4u of, ob;
                of.x = pk2(bflo(kv.x) * wf, bfhi(kv.x) * wf); of.y = pk2(bflo(kv.y) * wf, bfhi(kv.y) * wf); of.z = pk2(bflo(kv.z) * wf, bfhi(kv.z) * wf); of.w = pk2(bflo(kv.w) * wf, bfhi(kv.w) * wf);
                ob.x = pk2(bflo(kv.x) * wb, bfhi(kv.x) * wb); ob.y = pk2(bflo(kv.y) * wb, bfhi(kv.y) * wb); ob.z = pk2(bflo(kv.z) * wb, bfhi(kv.z) * wb); ob.w = pk2(bflo(kv.w) * wb, bfhi(kv.w) * wb);
                *(LAS v4u*)(lds + KF + r * 272 + qd * 64 + i * 16) = of; *(LAS v4u*)(lds + KB + r * 272 + qd * 64 + i * 16) = ob; }
            const v4u* vp = (const v4u*)(QKVG + (size_t)(row0 + r) * RET_IN + 2048 + h * 256 + qd * 64);
#pragma unroll
            for (int i = 0; i < 8; ++i) *(LAS v4u*)(lds + VS + r * 528 + qd * 128 + i * 16) = vp[i];
        }
        __syncthreads();
        float zf = 0.f; asm volatile("" : "+v"(zf)); const f32x4 zero4 = (f32x4){zf, zf, zf, zf};
        f32x4 af[16], ab[16];
#pragma unroll
        for (int c = 0; c < 16; ++c) { af[c] = zero4; ab[c] = zero4; }
#pragma unroll
        for (int ks = 0; ks < 4; ++ks) {
            const int ra = 32 * ks + 8 * g + q4;
            LAS const unsigned char* pa = lds + KF + ra * 272 + (16 * w + 4 * p4) * 2;
            const bf16x8 aF = cat8(ds_tr16(pa), ds_tr16(pa + 4 * 272));
            LAS const unsigned char* pb = lds + KB + ra * 272 + (16 * w + 4 * p4) * 2;
            const bf16x8 aB = cat8(ds_tr16(pb), ds_tr16(pb + 4 * 272));
#pragma unroll
            for (int c = 0; c < 16; ++c) {
                LAS const unsigned char* pv = lds + VS + ra * 528 + (16 * c + 4 * p4) * 2;
                const bf16x8 bv = cat8(ds_tr16(pv), ds_tr16(pv + 4 * 528));
                af[c] = mfma16(aF, bv, af[c]); ab[c] = mfma16(aB, bv, ab[c]);
            }
        }
        bf16* sf = ST + st_slot(0, b, h, idx) + (size_t)(16 * w + 4 * g) * 256 + l15; bf16* sb = ST + st_slot(1, b, h, idx) + (size_t)(16 * w + 4 * g) * 256 + l15;
#pragma unroll
        for (int c = 0; c < 16; ++c)
#pragma unroll
            for (int rg = 0; rg < 4; ++rg) { sf[rg * 256 + 16 * c] = (bf16)f2bf(af[c][rg]); sb[rg * 256 + 16 * c] = (bf16)f2bf(ab[c][rg]); }
    }
}
__device__ __forceinline__ void ph_ret_scan(const Params& P, int layer) {
    const int tid = tid_fresh();
    bf16* ST = (bf16*)(P.ws + WS_ST);
    for (int id = bid_fresh() * NTHR + tid; id < 32 * 4096; id += grid_fresh() * NTHR) {
        const int stream = id >> 12, off = (id & 4095) * 8, dir = stream >> 4, h = stream & 7;
        const float gC = expf(P.in[13][((layer >> 1) * 2 + dir) * 8 + h] * 128.f);
        bf16* base = ST + (size_t)stream * 66 * 32768 + off;
        float S[8];
#pragma unroll
        for (int k = 0; k < 8; ++k) { float zf = 0.f; asm volatile("" : "+v"(zf)); S[k] = zf; }
        for (int s0 = 0; s0 < 66; s0 += 6) {
            uint4 v[6];
#pragma unroll
            for (int uu = 0; uu < 6; ++uu) { const int sidx = s0 + uu; const int idx = dir ? (sidx < 2 ? 1 - sidx : 67 - sidx) : sidx; v[uu] = *(const uint4*)(base + (size_t)idx * 32768); }
#pragma unroll
            for (int uu = 0; uu < 6; ++uu) { const int sidx = s0 + uu; const int idx = dir ? (sidx < 2 ? 1 - sidx : 67 - sidx) : sidx;
                uint4 o; o.x = pk2(S[0], S[1]); o.y = pk2(S[2], S[3]); o.z = pk2(S[4], S[5]); o.w = pk2(S[6], S[7]);
                *(uint4*)(base + (size_t)idx * 32768) = o;
                S[0] = gC * S[0] + bflo(v[uu].x); S[1] = gC * S[1] + bfhi(v[uu].x); S[2] = gC * S[2] + bflo(v[uu].y); S[3] = gC * S[3] + bfhi(v[uu].y);
                S[4] = gC * S[4] + bflo(v[uu].z); S[5] = gC * S[5] + bfhi(v[uu].z); S[6] = gC * S[6] + bflo(v[uu].w); S[7] = gC * S[7] + bfhi(v[uu].w); }
        }
    }
}
__device__ __forceinline__ void ph_ret_out(const Params& P, int layer, LAS unsigned char* lds) {
    const int tid = tid_fresh(), lane = tid & 63, w = __builtin_amdgcn_readfirstlane(tid >> 6), l15 = lane & 15, g = lane >> 4, q4 = (lane & 15) >> 2, p4 = lane & 3;
    bf16* QKVG = (bf16*)(P.ws + WS_BIG1); const bf16* ST = (const bf16*)(P.ws + WS_ST);
    const int j = layer >> 1; const bool lastl = layer == DEPTH - 1;
    const float* gn = P.in[14] + (size_t)j * 2048;
    constexpr int QS = 0, KS = 34816, SL = 69632;
    for (int u = bid_fresh(); u < 16 * 66; u += grid_fresh()) {
        const int idx = u % 66, bh = u / 66, b = bh >> 3, h = bh & 7;
        if (lastl && idx < 2) continue;
        const int row0 = idx < 2 ? RL + b * LC + 128 * idx : b * T + 128 * (idx - 2);
        const float l2f = P.in[13][(j * 2 + 0) * 8 + h] * LOG2E, l2b = P.in[13][(j * 2 + 1) * 8 + h] * LOG2E;
        __syncthreads();
        {
            const int r = tid >> 2, qd = tid & 3;
            const v4u* qp = (const v4u*)(QKVG + (size_t)(row0 + r) * RET_IN + h * 128 + qd * 32);
            const v4u* kp = (const v4u*)(QKVG + (size_t)(row0 + r) * RET_IN + 1024 + h * 128 + qd * 32);
#pragma unroll
            for (int i = 0; i < 4; ++i) { *(LAS v4u*)(lds + QS + r * 272 + qd * 64 + i * 16) = qp[i]; *(LAS v4u*)(lds + KS + r * 272 + qd * 64 + i * 16) = kp[i]; }
        }
        __syncthreads();
        bf16x8 qf[4];
#pragma unroll
        for (int ks = 0; ks < 4; ++ks) qf[ks] = *(LAS const bf16x8*)(lds + QS + (16 * w + l15) * 272 + (32 * ks + 8 * g) * 2);
        float zf = 0.f; asm volatile("" : "+v"(zf)); const f32x4 zero4 = (f32x4){zf, zf, zf, zf};
        f32x4 pacc[8];
#pragma unroll
        for (int kt = 0; kt < 8; ++kt) { pacc[kt] = zero4;
#pragma unroll
            for (int ks = 0; ks < 4; ++ks) { const bf16x8 kf = *(LAS const bf16x8*)(lds + KS + (16 * kt + l15) * 272 + (32 * ks + 8 * g) * 2); pacc[kt] = mfma16(kf, qf[ks], pacc[kt]); } }
        const int qi = 16 * w + l15;
        bf16x8 pf[4];
#pragma unroll
        for (int sx = 0; sx < 4; ++sx) { unsigned pk[4];
#pragma unroll
            for (int e2 = 0; e2 < 4; ++e2) { float vv[2];
#pragma unroll
                for (int z = 0; z < 2; ++z) { const int e = 2 * e2 + z; const int kt = 2 * sx + (e >> 2), rg = e & 3; const int key = 16 * kt + 4 * g + rg; const int df = qi - key;
                    const float dec = df > 0 ? __builtin_amdgcn_exp2f(l2f * (float)df) : (df < 0 ? __builtin_amdgcn_exp2f(-l2b * (float)df) : 2.f);
                    vv[z] = pacc[kt][rg] * dec; }
                pk[e2] = pk2(vv[0], vv[1]); }
            pf[sx] = __builtin_bit_cast(bf16x8, (v4u){pk[0], pk[1], pk[2], pk[3]}); }
        const float dqf = __builtin_amdgcn_exp2f(l2f * (float)(qi + 1)), dqb = __builtin_amdgcn_exp2f(l2b * (float)(128 - qi));
        f32x4 acc[16];
#pragma unroll
        for (int c = 0; c < 16; ++c) acc[c] = zero4;
        const bf16* sfp = ST + st_slot(0, b, h, idx); const bf16* sbp = ST + st_slot(1, b, h, idx);
#pragma unroll
        for (int sl = 0; sl < 6; ++sl) {
            __syncthreads();
            {
                const int r = tid >> 3, pc = tid & 7;
                const v4u* src = sl < 2 ? (const v4u*)(QKVG + (size_t)(row0 + 64 * sl + r) * RET_IN + 2048 + h * 256 + pc * 32)
                                 : (sl < 4 ? (const v4u*)(sfp + (size_t)(64 * (sl - 2) + r) * 256 + pc * 32) : (const v4u*)(sbp + (size_t)(64 * (sl - 4) + r) * 256 + pc * 32));
#pragma unroll
                for (int i = 0; i < 4; ++i) *(LAS v4u*)(lds + SL + r * 528 + pc * 64 + i * 16) = src[i];
            }
            __syncthreads();
#pragma unroll
            for (int k2 = 0; k2 < 2; ++k2) {
                bf16x8 a;
                if (sl < 2) a = pf[2 * sl + k2];
                else { const float dq = sl < 4 ? dqf : dqb; const v4u qu = __builtin_bit_cast(v4u, qf[2 * ((sl - 2) & 1) + k2]); v4u t;
                    t.x = pk2(bflo(qu.x) * dq, bfhi(qu.x) * dq); t.y = pk2(bflo(qu.y) * dq, bfhi(qu.y) * dq); t.z = pk2(bflo(qu.z) * dq, bfhi(qu.z) * dq); t.w = pk2(bflo(qu.w) * dq, bfhi(qu.w) * dq);
                    a = __builtin_bit_cast(bf16x8, t); }
                const int r0 = sl < 2 ? 32 * k2 + 4 * g + q4 : 32 * k2 + 8 * g + q4, rstep = sl < 2 ? 16 : 4;
#pragma unroll
                for (int c = 0; c < 16; ++c) {
                    LAS const unsigned char* pv = lds + SL + r0 * 528 + (16 * c + 4 * p4) * 2;
                    const bf16x8 bv = cat8(ds_tr16(pv), ds_tr16(pv + rstep * 528));
                    acc[c] = mfma16(a, bv, acc[c]);
                    if ((c & 3) == 3) __builtin_amdgcn_sched_barrier(0);
                }
            }
        }
        float mu[4], rs[4];
#pragma unroll
        for (int rg = 0; rg < 4; ++rg) { float sm = 0.f;
#pragma unroll
            for (int c = 0; c < 16; ++c) sm += acc[c][rg];
            sm += __shfl_xor(sm, 1); sm += __shfl_xor(sm, 2); sm += __shfl_xor(sm, 4); sm += __shfl_xor(sm, 8); mu[rg] = sm * (1.f / 256.f);
            float qv = 0.f;
#pragma unroll
            for (int c = 0; c < 16; ++c) { const float dlt = acc[c][rg] - mu[rg]; qv += dlt * dlt; }
            qv += __shfl_xor(qv, 1); qv += __shfl_xor(qv, 2); qv += __shfl_xor(qv, 4); qv += __shfl_xor(qv, 8); rs[rg] = 1.f / sqrtf(qv * (1.f / 256.f) + EPS); }
#pragma unroll
        for (int rg = 0; rg < 4; ++rg) { bf16* rp = QKVG + (size_t)(row0 + 16 * w + 4 * g + rg) * RET_IN;
#pragma unroll
            for (int c = 0; c < 16; ++c) { const int col = h * 256 + 16 * c + l15; const float gg = bf2f(rp[4096 + col]);
                rp[2048 + col] = (bf16)f2bf(gg * ((acc[c][rg] - mu[rg]) * rs[rg] * gn[col])); } }
    }
}

__device__ __forceinline__ void ph_conv(const Params& P, int layer) {
    const bf16* A = (const bf16*)(P.ws + WS_BIG1); bf16* O = (bf16*)(P.ws + WS_BIG2);
    const float* cw = P.in[17] + (size_t)layer * 3 * FF2; const float* cb = P.in[18] + (size_t)layer * FF2;
    const size_t nit = (size_t)R * (FF / 8);
    for (size_t it = (size_t)bid_fresh() * NTHR + tid_fresh(); it < nit; it += (size_t)grid_fresh() * NTHR) {
        const int r = (int)(it / (FF / 8)), c0 = (int)(it % (FF / 8)) * 8;
        int s, len; if (r < RL) { s = r % T; len = T; } else { s = (r - RL) % LC; len = LC; }
        const bool hp = s > 0, hn = s < len - 1;
        float res[8];
#pragma unroll
        for (int half = 0; half < 2; ++half) {
            const int c = c0 + half * FF;
            const uint4 z = make_uint4(0u, 0u, 0u, 0u);
            const uint4 am = hp ? *(const uint4*)(A + (size_t)(r - 1) * FF2 + c) : z;
            const uint4 a0 = *(const uint4*)(A + (size_t)r * FF2 + c);
            const uint4 ap = hn ? *(const uint4*)(A + (size_t)(r + 1) * FF2 + c) : z;
            const unsigned um[4] = {am.x, am.y, am.z, am.w}, u0[4] = {a0.x, a0.y, a0.z, a0.w}, up[4] = {ap.x, ap.y, ap.z, ap.w};
#pragma unroll
            for (int e = 0; e < 8; ++e) {
                const float vm = (e & 1) ? bfhi(um[e >> 1]) : bflo(um[e >> 1]), v0 = (e & 1) ? bfhi(u0[e >> 1]) : bflo(u0[e >> 1]), vp = (e & 1) ? bfhi(up[e >> 1]) : bflo(up[e >> 1]);
                const float cv = cw[c + e] * vm + cw[FF2 + c + e] * v0 + cw[2 * FF2 + c + e] * vp + cb[c + e];
                if (half == 0) res[e] = silu_f(cv); else res[e] *= cv;
            }
        }
        uint4 w; w.x = pk2(res[0], res[1]); w.y = pk2(res[2], res[3]); w.z = pk2(res[4], res[5]); w.w = pk2(res[6], res[7]);
        *(uint4*)(O + (size_t)r * FF + c0) = w;
    }
}

__device__ __forceinline__ void ph_gemm_bf16(LAS unsigned char* lds, const bf16* A, int lda, const bf16* Bt, bf16* O, int N, int K) {
    pg8::Gemm g{A, Bt, R, N, K, lda}; pg8::StaticOrder S; S.init(R, N, (int)grid_fresh(), (int)bid_fresh());
    pg8::EpiBf16<0> E{O, N, nullptr, 0, 0, 1.f};
    pg8::gemm_phase<pg8::EpiBf16<0>, pg8::StaticOrder, true, true>(lds, g, S, E);
}
__device__ __forceinline__ void ph_gemm_f32(LAS unsigned char* lds, const bf16* A, int lda, const bf16* Bt, float* C, int N, int K) {
    pg8::Gemm g{A, Bt, R, N, K, lda}; pg8::StaticOrder S; S.init(R, N, (int)grid_fresh(), (int)bid_fresh());
    pg8::EpiF32 E{C, N, nullptr};
    pg8::gemm_phase<pg8::EpiF32, pg8::StaticOrder, true, true>(lds, g, S, E);
}

__device__ __forceinline__ void ph_gemm_hyb(LAS unsigned char* lds, const bf16* A, const bf16* Bt, bf16* O) {
    pg8::Gemm g{A, Bt, R, HYB_IN, D, D}; pg8::StaticOrder S; S.init(R, HYB_IN, (int)grid_fresh(), (int)bid_fresh());
    pg8::EpiHyb E{O};
    pg8::gemm_phase<pg8::EpiHyb, pg8::StaticOrder, true, true>(lds, g, S, E);
}
__device__ __forceinline__ void ph_gemm_ret(LAS unsigned char* lds, const bf16* A, const bf16* Bt, bf16* O, const float* tab) {
    pg8::Gemm g{A, Bt, R, RET_IN, D, D}; pg8::StaticOrder S; S.init(R, RET_IN, (int)grid_fresh(), (int)bid_fresh());
    pg8::EpiRet E{O, tab};
    pg8::gemm_phase<pg8::EpiRet, pg8::StaticOrder, true, true>(lds, g, S, E);
}
__global__ void __launch_bounds__(NTHR, 2) fwd_kernel(Params P) {
    extern __shared__ __attribute__((aligned(16))) unsigned char lds[];
    LAS unsigned char* ldsl = (LAS unsigned char*)lds;
    const int tid = tid_fresh();
    gu32* ctl = (gu32*)(P.ws + WS_CTL);
#if ONE_LAUNCH
    for (int u = tid; u < (LDS_BYTES - LDSCTL_OFF) / 4; u += NTHR) ((LAS unsigned*)(ldsl + LDSCTL_OFF))[u] = 0u;
    __syncthreads();
    (void)xcd_barrier_post((unsigned*)(ctl + CW_BAR), (volatile LAS unsigned*)(ldsl + MISC_OFF) + 8);
#endif
    const int ph_lo = P.ph_lo, ph_hi = P.ph_hi;
    enum { OP_WN, OP_GIN, OP_MIXE, OP_KV, OP_SCAN, OP_RETOUT, OP_GOUT, OP_RES1, OP_FIN, OP_CONV, OP_FOUT, OP_RES2 };
    for (int ph = ph_lo; ph < ph_hi; ++ph) {
        unsigned char* wsb = P.ws;
        bf16* WB = (bf16*)(wsb + WS_W); bf16* H = (bf16*)(wsb + WS_H); bf16* B1 = (bf16*)(wsb + WS_BIG1); bf16* B2 = (bf16*)(wsb + WS_BIG2);
        if (ph == 0) { ph_init(P, lds); }
        else {
            const int p = ph - 1; int layer, st;
            if (p < 9) { layer = 0; st = p; } else if (p < 20) { layer = 1; st = p - 9; } else if (p < 29) { layer = 2; st = p - 20; } else { layer = 3; st = p - 29; }
            const bool even = (layer & 1) == 0;
            int op;
            if (even) op = st == 0 ? OP_WN : st == 1 ? OP_GIN : st == 2 ? OP_MIXE : st == 3 ? OP_GOUT : st == 4 ? OP_RES1 : st == 5 ? OP_FIN : st == 6 ? OP_CONV : st == 7 ? OP_FOUT : OP_RES2;
            else op = st == 0 ? OP_WN : st == 1 ? OP_GIN : st == 2 ? OP_KV : st == 3 ? OP_SCAN : st == 4 ? OP_RETOUT : st == 5 ? OP_GOUT : st == 6 ? OP_RES1 : st == 7 ? OP_FIN : st == 8 ? OP_CONV : st == 9 ? OP_FOUT : OP_RES2;
            if (op == OP_FIN) ph_gemm_bf16(ldsl, H, D, WB + WO_FIN, B1, FF2, D);
            else if (op == OP_GIN && even) ph_gemm_hyb(ldsl, H, WB + WO_IN, B1);
            else if ((PHMASK & 4) && op == OP_GIN) ph_gemm_ret(ldsl, H, WB + WO_IN, B1, (const float*)(wsb + WS_ROPE));
            else if (op == OP_GOUT || op == OP_FOUT) {
                const bool ro = (op == OP_GOUT) && !even;
                ph_gemm_f32(ldsl, ro ? B1 + 2048 : B2, ro ? RET_IN : (op == OP_GOUT ? D : FF), WB + (op == OP_GOUT ? WO_OUT : WO_FOUT), ro ? (float*)B2 : (float*)B1, D, op == OP_GOUT ? (even ? D : 2048) : FF);
            }
            else if (op == OP_WN) { ph_wconv(P, layer, ldsl); ph_normmod(P, layer); }
            else if (op == OP_MIXE) { ph_attn(P, layer, ldsl); __syncthreads(); ph_sgu(P, layer, ldsl); }
            else if ((PHMASK & 1) && op == OP_KV) ph_ret_kv(P, layer, ldsl);
            else if (op == OP_SCAN) ph_ret_scan(P, layer);
            else if ((PHMASK & 2) && op == OP_RETOUT) ph_ret_out(P, layer, ldsl);
            else if (op == OP_RES1) ph_resid(P, layer, 1, (!even) ? (const float*)B2 : (const float*)B1);
            else if (op == OP_CONV) ph_conv(P, layer);
            else ph_resid(P, layer, 2, (const float*)B1);
        }
#if ONE_LAUNCH
        if (ph + 1 < ph_hi) {
            XcdBarrier bar; bar.bar = (unsigned*)((gu32*)(P.ws + WS_CTL) + CW_BAR); bar.x = xb_xcc_id(); bar.st = (volatile LAS unsigned*)(ldsl + MISC_OFF) + 8;
            xcd_barrier(bar); }
#endif
    }
}

extern "C" void kernel_launch(void* const* d_in, const int* in_sizes, int n_in, void* d_out, int out_size, void* d_ws, size_t ws_size, hipStream_t stream) {
    static int grid = 0;
    if (grid == 0) {
        if (n_in != 20 || out_size != RL * D || ws_size < WS_END) { fprintf(stderr, "kernel_launch: unexpected shapes (n_in %d out %d ws %zu)\n", n_in, out_size, ws_size); grid = -1; return; }
        int dev = 0, cus = 0;
        if (hipGetDevice(&dev) != hipSuccess || hipDeviceGetAttribute(&cus, hipDeviceAttributeMultiprocessorCount, dev) != hipSuccess) { grid = -1; return; }
        if (hipFuncSetAttribute((const void*)fwd_kernel, hipFuncAttributeMaxDynamicSharedMemorySize, LDS_BYTES) != hipSuccess) { grid = -1; return; }
        grid = cus;
    }
    if (grid < 0) return;
    (void)hipMemsetAsync((char*)d_ws + WS_CTL, 0, CTL_ZERO_BYTES, stream);
    Params p{};
    for (int i = 0; i < 20; ++i) p.in[i] = (const float*)d_in[i];
    p.out = (float*)d_out; p.ws = (unsigned char*)d_ws;
#if ONE_LAUNCH
    p.ph_lo = 0; p.ph_hi = NPHASE;
    hipLaunchKernelGGL(fwd_kernel, dim3(grid), dim3(NTHR), LDS_BYTES, stream, p);
#else
    for (int ph = 0; ph < NPHASE; ++ph) { p.ph_lo = ph; p.ph_hi = ph + 1; hipLaunchKernelGGL(fwd_kernel, dim3(grid), dim3(NTHR), LDS_BYTES, stream, p); }
#endif
}
```
